# Optimizing an MI355X kernel written in HIP

```python
import math
import jax
import jax.numpy as jnp
from jax import lax
import numpy as np

D_MODEL = 1024
BATCH = 4
SEQ = 8192
DEPTH = 2
DEC_BATCH = 2
DEC_SEQ = 8192
PAST_LEN = 128

GRID_W = 64
N_HEADS = 16
HEAD_DIM = 64
A_KV_HEADS = 4
A_GROUP = N_HEADS // A_KV_HEADS
ROPE_THETA = 10000.0
AXIS_DIM = HEAD_DIM // 2
NA_WIN_H_MAX = 8
NA_WIN_W = 16
NA_BIAS_H = 2 * NA_WIN_H_MAX - 1
NA_BIAS_W = 2 * NA_WIN_W - 1
Q_BLOCK = 128
NA_Q_BLOCK = GRID_W
D_FF = 4 * D_MODEL
NORM_EPS = 1e-6
N_A_LAYERS = (DEPTH + 1) // 2
N_B_LAYERS = DEPTH // 2

kernel_name = "hybrid_axial_gqa_natten_encoder"


def rms_norm(x, gain):
    xf = x.astype(jnp.float32)
    y = xf * lax.rsqrt(jnp.mean(xf * xf, axis=-1, keepdims=True) + NORM_EPS)
    return (y * gain.astype(jnp.float32)).astype(x.dtype)


def axial_rope_tables(seq):
    t = jnp.arange(seq)
    row = (t // GRID_W).astype(jnp.float32)
    col = (t % GRID_W).astype(jnp.float32)
    inv = ROPE_THETA ** (-jnp.arange(0, AXIS_DIM, 2, dtype=jnp.float32) / AXIS_DIM)
    ang = jnp.concatenate([row[:, None] * inv, col[:, None] * inv], axis=-1)
    return jnp.cos(ang), jnp.sin(ang)


def apply_axial_rope(x, cos, sin):
    b, s, h, _ = x.shape
    half = AXIS_DIM // 2
    xa = x.reshape(b, s, h, 2, AXIS_DIM)
    x1, x2 = xa[..., :half], xa[..., half:]
    c = cos.reshape(s, 1, 2, half)
    sn = sin.reshape(s, 1, 2, half)
    out = jnp.concatenate([x1 * c - x2 * sn, x2 * c + x1 * sn], axis=-1)
    return out.reshape(b, s, h, HEAD_DIM)


def global_axial_gqa(h, w_qkv, q_gain, k_gain, w_o):
    b, s, _ = h.shape
    qkv = h @ w_qkv
    q, k, v = jnp.split(qkv, [N_HEADS * HEAD_DIM, (N_HEADS + A_KV_HEADS) * HEAD_DIM], axis=-1)
    q = q.reshape(b, s, N_HEADS, HEAD_DIM)
    k = k.reshape(b, s, A_KV_HEADS, HEAD_DIM)
    v = v.reshape(b, s, A_KV_HEADS, HEAD_DIM)
    cos, sin = axial_rope_tables(s)
    q = (apply_axial_rope(rms_norm(q, q_gain).astype(jnp.float32), cos, sin) * HEAD_DIM ** -0.5).astype(h.dtype)
    k = apply_axial_rope(rms_norm(k, k_gain).astype(jnp.float32), cos, sin).astype(h.dtype)
    nblk = s // Q_BLOCK
    qb = q.reshape(b, nblk, Q_BLOCK, A_KV_HEADS, A_GROUP, HEAD_DIM).transpose(1, 0, 2, 3, 4, 5)

    def block(qi):
        sc = jnp.einsum('bqkgd,bskd->bkgqs', qi, k, preferred_element_type=jnp.float32)
        p = jax.nn.softmax(sc, axis=-1).astype(v.dtype)
        return jnp.einsum('bkgqs,bskd->bqkgd', p, v)

    o = lax.map(block, qb)
    o = o.transpose(1, 0, 2, 3, 4, 5).reshape(b, s, N_HEADS * HEAD_DIM)
    return o @ w_o


def neighbourhood_indices(rows):
    kh = min(NA_WIN_H_MAX, rows)
    s = rows * GRID_W
    t = jnp.arange(s)
    r = t // GRID_W
    c = t % GRID_W
    r0 = jnp.clip(r - kh // 2, 0, rows - kh)
    c0 = jnp.clip(c - NA_WIN_W // 2, 0, GRID_W - NA_WIN_W)
    kr = r0[:, None] + jnp.arange(kh)[None, :]
    kc = c0[:, None] + jnp.arange(NA_WIN_W)[None, :]
    key_idx = (kr[:, :, None] * GRID_W + kc[:, None, :]).reshape(s, kh * NA_WIN_W)
    dr = kr - r[:, None] + (NA_WIN_H_MAX - 1)
    dc = kc - c[:, None] + (NA_WIN_W - 1)
    bias_idx = (dr[:, :, None] * NA_BIAS_W + dc[:, None, :]).reshape(s, kh * NA_WIN_W)
    return key_idx, bias_idx


def neighbourhood_attention(h, w_qkv, rel_bias, w_o):
    b, s, _ = h.shape
    rows = s // GRID_W
    qkv = h @ w_qkv
    q, k, v = jnp.split(qkv, 3, axis=-1)
    q = q.reshape(b, s, N_HEADS, HEAD_DIM) * HEAD_DIM ** -0.5
    k = k.reshape(b, s, N_HEADS, HEAD_DIM)
    v = v.reshape(b, s, N_HEADS, HEAD_DIM)
    key_idx, bias_idx = neighbourhood_indices(rows)
    kn = key_idx.shape[-1]
    nblk = s // NA_Q_BLOCK
    qb = q.reshape(b, nblk, NA_Q_BLOCK, N_HEADS, HEAD_DIM).swapaxes(0, 1)
    kib = key_idx.reshape(nblk, NA_Q_BLOCK, kn)
    bib = bias_idx.reshape(nblk, NA_Q_BLOCK, kn)
    table = rel_bias.reshape(N_HEADS, NA_BIAS_H * NA_BIAS_W)

    def block(args):
        qi, ki, bi = args
        kg = jnp.take(k, ki, axis=1)
        vg = jnp.take(v, ki, axis=1)
        sc = jnp.einsum('bqhd,bqnhd->bhqn', qi, kg, preferred_element_type=jnp.float32)
        sc = sc + jnp.take(table, bi, axis=1).astype(jnp.float32)
        p = jax.nn.softmax(sc, axis=-1).astype(v.dtype)
        return jnp.einsum('bhqn,bqnhd->bqhd', p, vg)

    o = lax.map(block, (qb, kib, bib))
    o = o.swapaxes(0, 1).reshape(b, s, N_HEADS * HEAD_DIM)
    return o @ w_o


def sq_relu_mlp(h, w_in, w_out):
    u = jax.nn.relu(h @ w_in)
    return (u * u) @ w_out


def trunk(x, norm_mix, norm_mlp, norm_final, a_w_qkv, a_q_norm, a_k_norm, a_w_o,
          b_w_qkv, b_rel_bias, b_w_o, mlp_w_in, mlp_w_out):
    for i in range(DEPTH):
        j = i // 2
        h = rms_norm(x, norm_mix[i])
        if i % 2 == 0:
            x = x + global_axial_gqa(h, a_w_qkv[j], a_q_norm[j], a_k_norm[j], a_w_o[j])
        else:
            x = x + neighbourhood_attention(h, b_w_qkv[j], b_rel_bias[j], b_w_o[j])
        x = x + sq_relu_mlp(rms_norm(x, norm_mlp[i]), mlp_w_in[i], mlp_w_out[i])
    return rms_norm(x, norm_final)


def setup_inputs(seed: int = 0) -> dict:
    key = jax.random.key(seed)
    ks = jax.random.split(key, 16)
    f32 = jnp.float32
    hd = N_HEADS * HEAD_DIM
    a_qkv_w = (N_HEADS + 2 * A_KV_HEADS) * HEAD_DIM
    nrm = lambda k, shape, scale: jax.random.normal(k, shape, f32) * scale
    return {
        "x_prompt": jax.random.normal(ks[0], (BATCH, SEQ, D_MODEL), f32),
        "x_sample": jax.random.normal(ks[1], (DEC_BATCH, DEC_SEQ, D_MODEL), f32),
        "norm_mix": 1.0 + nrm(ks[2], (DEPTH, D_MODEL), 0.05),
        "norm_mlp": 1.0 + nrm(ks[3], (DEPTH, D_MODEL), 0.05),
        "norm_final": 1.0 + nrm(ks[4], (D_MODEL,), 0.05),
        "a_w_qkv": nrm(ks[5], (N_A_LAYERS, D_MODEL, a_qkv_w), D_MODEL ** -0.5),
        "a_q_norm": 1.0 + nrm(ks[6], (N_A_LAYERS, HEAD_DIM), 0.05),
        "a_k_norm": 1.0 + nrm(ks[7], (N_A_LAYERS, HEAD_DIM), 0.05),
        "a_w_o": nrm(ks[8], (N_A_LAYERS, hd, D_MODEL), hd ** -0.5),
        "b_w_qkv": nrm(ks[9], (N_B_LAYERS, D_MODEL, 3 * hd), D_MODEL ** -0.5),
        "b_rel_bias": nrm(ks[10], (N_B_LAYERS, N_HEADS, NA_BIAS_H, NA_BIAS_W), 0.1),
        "b_w_o": nrm(ks[11], (N_B_LAYERS, hd, D_MODEL), hd ** -0.5),
        "mlp_w_in": nrm(ks[12], (DEPTH, D_MODEL, D_FF), D_MODEL ** -0.5),
        "mlp_w_out": nrm(ks[13], (DEPTH, D_FF, D_MODEL), D_FF ** -0.5),
    }


def reference(x_prompt, x_sample, norm_mix, norm_mlp, norm_final, a_w_qkv, a_q_norm, a_k_norm,
              a_w_o, b_w_qkv, b_rel_bias, b_w_o, mlp_w_in, mlp_w_out):
    y_prompt = trunk(x_prompt, norm_mix, norm_mlp, norm_final, a_w_qkv, a_q_norm, a_k_norm, a_w_o,
                     b_w_qkv, b_rel_bias, b_w_o, mlp_w_in, mlp_w_out)
    y_sample = trunk(x_sample, norm_mix, norm_mlp, norm_final, a_w_qkv, a_q_norm, a_k_norm, a_w_o,
                     b_w_qkv, b_rel_bias, b_w_o, mlp_w_in, mlp_w_out)
    return (y_prompt, y_sample)
```

```cpp
#include <hip/hip_runtime.h>
#include <hip/hip_cooperative_groups.h>
#include <hip/hip_bf16.h>
#include <cstdio>
#include <cstdint>
#include <cmath>
namespace pg8 {
#define PG8_LAS __attribute__((address_space(3)))
typedef unsigned short bf16_t;
typedef short bf16x8 __attribute__((ext_vector_type(8)));
typedef float f32x4 __attribute__((ext_vector_type(4)));
typedef unsigned u32x4 __attribute__((ext_vector_type(4)));
constexpr int BM = 256, BK = 64, HALF = 128, HTB = HALF * BK * 2  , STAGE_BYTES = 8 * HTB, NXCD = 8, WGM = 4;

__host__ __device__ __forceinline__ int lds_byte(int r, int c) { const int st = (r >> 4) * 2 + (c >> 5), rr = r & 15, cc = c & 31, ob = rr * 64 + cc * 2; return st * 1024 + (ob ^ (((ob >> 9) & 1) << 5)); }
__host__ __device__ __forceinline__ void stage_rc(int b, int& R, int& C) { const int st = b / 1024, sb = b % 1024, swz = sb ^ (((sb >> 9) & 1) << 5); R = (st >> 1) * 16 + swz / 64; C = (st & 1) * 32 + (swz % 64) / 2; }
__host__ __device__ __forceinline__ int perm32(int rho) { const int n = rho >> 4, i = rho & 15; return 8 * (i >> 2) + 4 * n + (i & 3); }

__host__ __device__ __forceinline__ size_t img_off(int row, int col, int KT) { return ((size_t)(row >> 7) * KT + (col >> 6)) * 16384 + lds_byte(row & 127, col & 63); }
struct Unit { int pm, pn; };
struct Gemm { const bf16_t* A; const bf16_t* Bt; int M, N, K; bool a_img; int amod = 0; size_t a_hstep = 0; };

struct StaticOrder {
    int nM, nN, nwg, G, c, rev;
    __host__ __device__ void init(int M, int N, int G_, int c_, int rev_ = 0) { nM = M / BM; nN = N / BM; nwg = nM * nN; G = G_; c = c_; rev = rev_; }
    __host__ __device__ bool next(int i, Unit& u) const {
        const long L = (long)i * G + c; if (L >= nwg) return false;
        int wgid = (int)L; { const int q = nwg / NXCD, r = nwg % NXCD, xcd = wgid % NXCD, off = wgid / NXCD; wgid = (xcd < r ? xcd * (q + 1) : r * (q + 1) + (xcd - r) * q) + off; }
        const int nig = WGM * nN, gid = wgid / nig, fm = gid * WGM, gsz = (nM - fm) < WGM ? (nM - fm) : WGM;
        u.pm = fm + ((wgid % nig) % gsz); u.pn = (wgid % nig) / gsz; if (rev) u.pm = nM - 1 - u.pm; return true;
    }
    __device__ __forceinline__ void a_ready(const Unit&) const {}
    __device__ __forceinline__ void done(const Unit&) const {}
};

__device__ __forceinline__ unsigned cvt_pk_bf16(float lo, float hi) { unsigned r; asm volatile("v_cvt_pk_bf16_f32 %0, %1, %2" : "=v"(r) : "v"(lo), "v"(hi)); return r; }
typedef float f32x2 __attribute__((ext_vector_type(2)));
#define PG8_APM(pm) (g.amod ? (pm) % g.amod : (pm))
template <class Epi, class Sched, bool ALIGN_EPI = false, bool SP2 = false, int A_AUX = 0  >
__device__ __forceinline__ void gemm_phase(PG8_LAS unsigned char* lds, const Gemm g, const Sched& S, const Epi& E) {
    int tid_ = threadIdx.x; asm volatile("" : "+v"(tid_));
    const int tid = tid_, wid = __builtin_amdgcn_readfirstlane(tid >> 6), lane = tid & 63, wr = wid >> 2, wc = wid & 3, fr = lane & 15, fq = lane >> 4;
    const int K = g.K, nt = K / BK;
    unsigned voffA[2], voffB[2];
#pragma unroll
    for (int i = 0; i < 2; ++i) { int R, C; stage_rc(tid * 16 + i * 8192, R, C); const int Rb = Epi::PERM ? ((R & ~31) + perm32(R & 31)) : R;
        (void)Rb;
        voffA[i] = g.a_img ? (unsigned)(tid * 16 + i * 8192) : (unsigned)(R * K + C) * 2u; voffB[i] = (unsigned)(tid * 16 + i * 8192); }
    const size_t kstep = g.a_img ? (size_t)(2 * HTB / 2) : (size_t)(BK * 2);
    const size_t kstepB = (size_t)HTB;
    const size_t hstep = (size_t)HALF * K * 2;
    const size_t tstep = 2 * hstep;
    const size_t hstepA = g.a_hstep ? g.a_hstep : hstep, tstepA = 2 * hstepA;
    const unsigned ldsw = (unsigned)wid * 1024u;
    const int aoff = lds_byte(wr * 64 + fr, fq * 8), boff = lds_byte(wc * 32 + fr, fq * 8);
#define PG8_SA(b, h) (((b) * 2 + (h)) * HTB)
#define PG8_SB(b, h) ((4 + (b) * 2 + (h)) * HTB)
#define PG8_STAGEA(bufoff, gbase, voff) do { _Pragma("unroll") for (int _i = 0; _i < 2; ++_i) \
        __builtin_amdgcn_global_load_lds((const unsigned*)((const char*)(gbase) + (voff)[_i]), (PG8_LAS unsigned*)(lds + (bufoff) + ldsw + _i * 8192), 16, 0, A_AUX); } while (0)
#define PG8_STAGE(bufoff, gbase, voff) do { _Pragma("unroll") for (int _i = 0; _i < 2; ++_i) \
        __builtin_amdgcn_global_load_lds((const unsigned*)((const char*)(gbase) + (voff)[_i]), (PG8_LAS unsigned*)(lds + (bufoff) + ldsw + _i * 8192), 16, 0, 0); } while (0)
#define PG8_LDA(dst, b, h) do { _Pragma("unroll") for (int m = 0; m < 4; ++m) _Pragma("unroll") for (int k = 0; k < 2; ++k) dst[m][k] = *(const PG8_LAS bf16x8*)(lds + PG8_SA(b, h) + aoff + m * 2048 + k * 1024); } while (0)
#define PG8_LDB(dst, b, h) do { _Pragma("unroll") for (int n = 0; n < 2; ++n) _Pragma("unroll") for (int k = 0; k < 2; ++k) dst[n][k] = *(const PG8_LAS bf16x8*)(lds + PG8_SB(b, h) + boff + n * 2048 + k * 1024); } while (0)
#define PG8_MMA(ai, bj, At, Bt) do { __builtin_amdgcn_s_setprio(1); _Pragma("unroll") for (int m = 0; m < 4; ++m) _Pragma("unroll") for (int n = 0; n < 2; ++n) _Pragma("unroll") for (int k = 0; k < 2; ++k) \
        acc[ai][bj][m][n] = __builtin_amdgcn_mfma_f32_16x16x32_bf16(Bt[n][k], At[m][k], acc[ai][bj][m][n], 0, 0, 0); __builtin_amdgcn_s_setprio(0); } while (0)
#define PG8_WAIT_V(n) asm volatile("s_waitcnt vmcnt(" #n ")" ::: "memory")
#define PG8_WAIT_L(n) asm volatile("s_waitcnt lgkmcnt(" #n ")" ::: "memory")
#define PG8_BAR __builtin_amdgcn_s_barrier()
#define PG8_SCHED __builtin_amdgcn_sched_barrier(0)
    Unit cur, nxt; int ui = 0;
    if (!S.next(0, cur)) return;
    f32x4 acc[2][2][4][2]; typename Epi::Carry carry;
    E.init(acc, carry, cur, wr, wc, fr, fq);
    bf16x8 At[4][2], B0[2][2], B1[2][2];
    const char* cA = (const char*)g.A + (size_t)PG8_APM(cur.pm) * tstepA; const char* cB = (const char*)g.Bt + (size_t)cur.pn * tstep;
    S.a_ready(cur);
    if constexpr (SP2) {
        PG8_STAGE(PG8_SB(0, 0), cB, voffB); PG8_STAGE(PG8_SB(0, 1), cB + hstep, voffB); PG8_STAGEA(PG8_SA(0, 0), cA, voffA); PG8_STAGEA(PG8_SA(0, 1), cA + hstepA, voffA);
        if (wr == 1) PG8_BAR;
        PG8_WAIT_V(2); PG8_BAR;
        PG8_STAGE(PG8_SB(1, 0), cB + kstepB, voffB); PG8_STAGEA(PG8_SA(1, 0), cA + kstep, voffA); PG8_STAGE(PG8_SB(1, 1), cB + hstep + kstepB, voffB);
        PG8_WAIT_V(6); PG8_BAR;
    } else {
        PG8_STAGE(PG8_SB(0, 0), cB, voffB); PG8_STAGEA(PG8_SA(0, 0), cA, voffA); PG8_STAGE(PG8_SB(0, 1), cB + hstep, voffB); PG8_STAGEA(PG8_SA(0, 1), cA + hstepA, voffA);
        if (wr == 1) PG8_BAR;
        PG8_WAIT_V(4); PG8_BAR;
        PG8_STAGE(PG8_SB(1, 0), cB + kstepB, voffB); PG8_STAGEA(PG8_SA(1, 0), cA + kstep, voffA); PG8_STAGE(PG8_SB(1, 1), cB + hstep + kstepB, voffB);
        PG8_WAIT_V(6); PG8_BAR;
    }
    for (;;) {
        const bool has_next = S.next(ui + 1, nxt);
        const char* nA = has_next ? (const char*)g.A + (size_t)PG8_APM(nxt.pm) * tstepA : cA; const char* nB = has_next ? (const char*)g.Bt + (size_t)nxt.pn * tstep : cB;
        for (int t = 0; t < nt; t += 2) {
            const bool last = (t == nt - 2);
            const char* a1 = cA + (size_t)(t + 1) * kstep;
            const char* a2 = last ? nA : cA + (size_t)(t + 2) * kstep; const char* b2 = last ? nB : cB + (size_t)(t + 2) * kstepB;
            const char* a3 = a2 + kstep; const char* b3 = b2 + kstepB;
            if (last && has_next) S.a_ready(nxt);
            if constexpr (SP2) {
            PG8_LDB(B0, 0, 0); PG8_LDB(B1, 0, 1); PG8_SCHED; PG8_LDA(At, 0, 0); PG8_STAGEA(PG8_SA(1, 1), a1 + hstepA, voffA);
            PG8_WAIT_V(8); PG8_WAIT_L(0); PG8_BAR; PG8_MMA(0, 0, At, B0); PG8_MMA(0, 1, At, B1); PG8_BAR; PG8_SCHED;
            PG8_LDA(At, 0, 1); PG8_STAGE(PG8_SB(0, 0), b2, voffB); PG8_STAGE(PG8_SB(0, 1), b2 + hstep, voffB); PG8_STAGEA(PG8_SA(0, 0), a2, voffA);
            PG8_WAIT_V(8); PG8_WAIT_L(0); PG8_BAR; PG8_MMA(1, 0, At, B0); PG8_MMA(1, 1, At, B1); PG8_BAR; PG8_SCHED;
            PG8_LDB(B0, 1, 0); PG8_LDB(B1, 1, 1); PG8_SCHED; PG8_LDA(At, 1, 0); PG8_STAGEA(PG8_SA(0, 1), a2 + hstepA, voffA);
            PG8_WAIT_V(8); PG8_WAIT_L(0); PG8_BAR; PG8_MMA(0, 0, At, B0); PG8_MMA(0, 1, At, B1); PG8_BAR; PG8_SCHED;
            PG8_LDA(At, 1, 1); PG8_STAGE(PG8_SB(1, 0), b3, voffB); PG8_STAGE(PG8_SB(1, 1), b3 + hstep, voffB); PG8_STAGEA(PG8_SA(1, 0), a3, voffA);
            PG8_WAIT_V(8); PG8_WAIT_L(0); PG8_BAR; PG8_MMA(1, 0, At, B0); PG8_MMA(1, 1, At, B1); PG8_BAR; PG8_SCHED;
            } else {
            PG8_LDB(B0, 0, 0); PG8_SCHED; PG8_LDA(At, 0, 0); PG8_STAGEA(PG8_SA(1, 1), a1 + hstepA, voffA);
            PG8_WAIT_L(8); PG8_BAR; PG8_WAIT_L(0); PG8_MMA(0, 0, At, B0); PG8_BAR; PG8_SCHED;
            PG8_LDB(B1, 0, 1); PG8_STAGE(PG8_SB(0, 0), b2, voffB);
            PG8_BAR; PG8_WAIT_L(0); PG8_MMA(0, 1, At, B1); PG8_BAR;
            PG8_LDA(At, 0, 1); PG8_STAGEA(PG8_SA(0, 0), a2, voffA);
            PG8_BAR; PG8_WAIT_L(0); PG8_MMA(1, 0, At, B0); PG8_BAR; PG8_SCHED;
            PG8_STAGE(PG8_SB(0, 1), b2 + hstep, voffB);
            PG8_WAIT_V(6); PG8_BAR; PG8_MMA(1, 1, At, B1); PG8_BAR;
            PG8_LDB(B0, 1, 0); PG8_SCHED; PG8_LDA(At, 1, 0); PG8_STAGEA(PG8_SA(0, 1), a2 + hstepA, voffA);
            PG8_WAIT_L(8); PG8_BAR; PG8_WAIT_L(0); PG8_MMA(0, 0, At, B0); PG8_BAR; PG8_SCHED;
            PG8_LDB(B1, 1, 1); PG8_STAGE(PG8_SB(1, 0), b3, voffB);
            PG8_BAR; PG8_WAIT_L(0); PG8_MMA(0, 1, At, B1); PG8_BAR;
            PG8_LDA(At, 1, 1); PG8_STAGEA(PG8_SA(1, 0), a3, voffA);
            PG8_BAR; PG8_WAIT_L(0); PG8_MMA(1, 0, At, B0); PG8_BAR; PG8_SCHED;
            PG8_STAGE(PG8_SB(1, 1), b3 + hstep, voffB);
            PG8_WAIT_V(6); PG8_BAR; PG8_MMA(1, 1, At, B1); PG8_BAR;
            }
        }
        if constexpr (ALIGN_EPI) { if (wr == 0) PG8_BAR; }
        if constexpr (!Epi::AFTER_DRAIN) { E(acc, carry, cur, wr, wc, fr, fq); S.done(cur); }
        if (!has_next) break;
        E.init(acc, carry, nxt, wr, wc, fr, fq);
        cur = nxt; cA = nA; cB = nB; ++ui;
        if constexpr (ALIGN_EPI) { if (wr == 1) PG8_BAR; }
    }
    PG8_WAIT_V(0);
    if constexpr (!ALIGN_EPI) { if (wr == 0) PG8_BAR; }
    PG8_BAR;

#undef PG8_SA
#undef PG8_SB
#undef PG8_STAGE
#undef PG8_STAGEA
#undef PG8_LDA
#undef PG8_LDB
#undef PG8_MMA
#undef PG8_WAIT_V
#undef PG8_WAIT_L
#undef PG8_BAR
#undef PG8_SCHED
}
}

#ifndef PG8_SP2
#define PG8_SP2 true
#endif
#ifndef PG8_ALIGN
#define PG8_ALIGN true
#endif
namespace attn_body {
using bf16=__hip_bfloat16;
using bf16x8=__attribute__((ext_vector_type(8)))short;
using s16x4=__attribute__((ext_vector_type(4)))short;
using f32x16=__attribute__((ext_vector_type(16)))float;
using u32x4=__attribute__((ext_vector_type(4)))unsigned;
constexpr int BATCH=6,NHEAD=16,SEQ=8192,D=64,DM=NHEAD*D;
constexpr int NW=8,QBLK=32,QB=QBLK*NW,KVBLK=64,NQB=SEQ/QB;
constexpr int ATTN_PITCH=DM, ATTN_UNIT_ROWS=QB;
constexpr int NT_IMG=SEQ/KVBLK;
__device__ __forceinline__ int crow(int r,int hi){return (r&3)+8*(r>>2)+4*hi;}
#define SBAR() __builtin_amdgcn_sched_barrier(0)
__device__ __forceinline__ void cmask(f32x16&p0,f32x16&p1,int jb,int qrel,int hi){
  const float NEG=-INFINITY; int kb=64*jb+4*hi;
  #pragma unroll
  for(int r=0;r<16;++r){int kv=kb+(r&3)+8*(r>>2); if(kv>qrel)p0[r]=NEG; if(kv+32>qrel)p1[r]=NEG;}
}

constexpr int NSLOT=3, SLOTB=8192;
constexpr int LDS_K=0, LDS_V=NSLOT*SLOTB, LDS_WS=2*NSLOT*SLOTB, LDS_OST=LDS_WS+NW*64*4, LDS_BYTES=LDS_OST+NW*4096;
constexpr float C2=0.125f*1.4426950408889634f;
__device__ __forceinline__ void glds16(const void*gsrc,unsigned lds_dst){unsigned keep;
  asm volatile("s_mov_b32 %0, m0\n\ts_mov_b32 m0, %2\n\ts_nop 0\n\tglobal_load_lds_dwordx4 %1, off\n\ts_mov_b32 m0, %0":"=&s"(keep):"v"(gsrc),"s"(lds_dst):"memory");}
__device__ __forceinline__ float max3f(float a,float b,float c){float r;asm("v_max3_f32 %0, %1, %2, %3":"=v"(r):"v"(a),"v"(b),"v"(c));return r;}
__device__ __forceinline__ float max2f(float a,float b){float r;asm("v_max_f32_e32 %0, %1, %2":"=v"(r):"v"(a),"v"(b));return r;}
__device__ __forceinline__ float fadd_s(float a,float b){float r;asm("v_add_f32_e32 %0, %1, %2":"=v"(r):"v"(a),"v"(b));return r;}
__device__ __forceinline__ float fsub_s(float a,float b){float r;asm("v_sub_f32_e32 %0, %1, %2":"=v"(r):"v"(a),"v"(b));return r;}
typedef float f32x2_t __attribute__((ext_vector_type(2))); typedef __bf16 bf16x2_t __attribute__((ext_vector_type(2)));
__device__ __forceinline__ unsigned cvtpk_s(float lo,float hi){f32x2_t v={lo,hi};bf16x2_t b=__builtin_convertvector(v,bf16x2_t);return __builtin_bit_cast(unsigned,b);}
#define WAIT_BAR(N) asm volatile("s_waitcnt vmcnt(" #N ") lgkmcnt(0)\n\ts_barrier":::"memory")

__device__ __forceinline__ void qkt(f32x16&p0,f32x16&p1,const char*Kslot,const bf16x8*qr,const f32x16&negm,int r32,int hi){
  const char*kb=Kslot+hi*1024+r32*16;
  #pragma unroll
  for(int d0=0;d0<4;++d0){
    const bf16x8 b0=*reinterpret_cast<const bf16x8*>(kb+d0*2048);
    const bf16x8 b1=*reinterpret_cast<const bf16x8*>(kb+d0*2048+512);
    if(d0==0){p0=__builtin_amdgcn_mfma_f32_32x32x16_bf16(b0,qr[0],negm,0,0,0);p1=__builtin_amdgcn_mfma_f32_32x32x16_bf16(b1,qr[0],negm,0,0,0);}
    else{p0=__builtin_amdgcn_mfma_f32_32x32x16_bf16(b0,qr[d0],p0,0,0,0);p1=__builtin_amdgcn_mfma_f32_32x32x16_bf16(b1,qr[d0],p1,0,0,0);}}
}
typedef __attribute__((address_space(3))) const char* lds_cptr;
typedef short v4i16_t __attribute__((ext_vector_type(4)));
__device__ __forceinline__ void kload8(bf16x8*kf,lds_cptr kp){
  kf[0]=*(const __attribute__((address_space(3))) bf16x8*)(kp);      kf[1]=*(const __attribute__((address_space(3))) bf16x8*)(kp+512);
  kf[2]=*(const __attribute__((address_space(3))) bf16x8*)(kp+2048); kf[3]=*(const __attribute__((address_space(3))) bf16x8*)(kp+2560);
  kf[4]=*(const __attribute__((address_space(3))) bf16x8*)(kp+4096); kf[5]=*(const __attribute__((address_space(3))) bf16x8*)(kp+4608);
  kf[6]=*(const __attribute__((address_space(3))) bf16x8*)(kp+6144); kf[7]=*(const __attribute__((address_space(3))) bf16x8*)(kp+6656);
}
__device__ __forceinline__ void kload2(bf16x8*kf,lds_cptr kp,int j){ kf[2*j]=*(const __attribute__((address_space(3))) bf16x8*)(kp+j*2048); kf[2*j+1]=*(const __attribute__((address_space(3))) bf16x8*)(kp+j*2048+512); }
__device__ __forceinline__ s16x4 vtr(lds_cptr p){ return __builtin_bit_cast(s16x4,__builtin_amdgcn_ds_read_tr16_b64_v4i16((__attribute__((address_space(3))) v4i16_t*)p)); }
__device__ __forceinline__ float rowmax(const f32x16&p0,const f32x16&p1){
  float a=max3f(p0[0],p0[1],p1[0]),b=max3f(p0[2],p0[3],p1[1]);a=max3f(a,p1[2],p1[3]);
  #pragma unroll
  for(int r=4;r<16;r+=4){a=max3f(a,p0[r],p0[r+1]);b=max3f(b,p0[r+2],p0[r+3]);a=max3f(a,p1[r],p1[r+1]);b=max3f(b,p1[r+2],p1[r+3]);}
  const float m=max2f(a,b);
  auto rr=__builtin_amdgcn_permlane32_swap(__float_as_uint(m),__float_as_uint(m),false,false);
  return max2f(__uint_as_float(rr[0]),__uint_as_float(rr[1]));
}
__device__ __forceinline__ void pv(f32x16*o,int vb,bf16x8 pa0,bf16x8 pa1,bf16x8 pa2,bf16x8 pa3){
  #pragma unroll
  for(int d0=0;d0<2;++d0){s16x4 lo[4],hi[4];
    #pragma unroll
    for(int ks=0;ks<4;++ks){
      asm volatile("ds_read_b64_tr_b16 %0,%1 offset:%c2":"=&v"(lo[ks]):"v"(vb),"i"(d0*4096+ks*1024):"memory");
      asm volatile("ds_read_b64_tr_b16 %0,%1 offset:%c2":"=&v"(hi[ks]):"v"(vb),"i"(d0*4096+ks*1024+512):"memory");}
    asm volatile("s_waitcnt lgkmcnt(0)":::"memory");SBAR();
    #define PK(k) (bf16x8){lo[k][0],lo[k][1],lo[k][2],lo[k][3],hi[k][0],hi[k][1],hi[k][2],hi[k][3]}
    o[d0]=__builtin_amdgcn_mfma_f32_32x32x16_bf16(pa0,PK(0),o[d0],0,0,0);
    o[d0]=__builtin_amdgcn_mfma_f32_32x32x16_bf16(pa1,PK(1),o[d0],0,0,0);
    o[d0]=__builtin_amdgcn_mfma_f32_32x32x16_bf16(pa2,PK(2),o[d0],0,0,0);
    o[d0]=__builtin_amdgcn_mfma_f32_32x32x16_bf16(pa3,PK(3),o[d0],0,0,0);
    #undef PK
  }
}

#ifndef ATTN_STORE16
#define ATTN_STORE16(p,v) (*(u32x4*)(p)=(v))
#endif
template<int THRL,int KP> __device__ __forceinline__ void attn_unit(int b,int h,int kvh,int qb,const bf16*Q,const bf16*__restrict__ K,const bf16*__restrict__ V,bf16*O,char*shm){
  int tid_=threadIdx.x; asm volatile("":"+v"(tid_));
  const int tid=tid_,lane=tid&63,r32=lane&31,hi=lane>>5; const int wid=__builtin_amdgcn_readfirstlane(tid>>6);
  const long rowbase=(long)b*SEQ; const int q0=qb*QB;
  const bf16*Qw=Q+(rowbase+q0+wid*QBLK)*DM+h*D;
  const bf16*Kh=K+((long)b*KP+kvh)*(long)(NT_IMG*4096),*Vh=V+((long)b*KP+kvh)*(long)(NT_IMG*4096);
  const unsigned lds0=(unsigned)(uintptr_t)shm;
  float*wsf=(float*)(shm+LDS_WS)+wid*64;
  const bf16*ksrc=Kh+wid*512+lane*8;
  const bf16*vsrc=Vh+wid*512+lane*8;
  const unsigned kdst=lds0+LDS_K+wid*1024, vdst=lds0+LDS_V+wid*1024;
  #define DMA_K(t,slot) glds16(ksrc+(long)(t)*4096,(unsigned)__builtin_amdgcn_readfirstlane(kdst+(slot)))
  #define DMA_V(t,slot) glds16(vsrc+(long)(t)*4096,(unsigned)__builtin_amdgcn_readfirstlane(vdst+(slot)))
  const int vb0=(int)(lds0+LDS_V)+((lane>>4)&1)*32+(lane&3)*8+(4*hi+((lane&15)>>2))*64;
  const char*Kbase=shm+LDS_K; bf16x8 kf[8];
  const lds_cptr shm3=(lds_cptr)shm; const lds_cptr kp0=shm3+LDS_K+hi*1024+r32*16; const lds_cptr vp0=shm3+LDS_V+((lane>>4)&1)*32+(lane&3)*8+(4*hi+((lane&15)>>2))*64;
  const int NT=SEQ/KVBLK;
  DMA_K(0,0);DMA_V(0,0);DMA_K(1,SLOTB);
  bf16x8 qr[4];
  #pragma unroll
  for(int d0=0;d0<4;++d0)qr[d0]=*reinterpret_cast<const bf16x8*>(&Qw[(long)r32*DM+d0*16+hi*8]);
  asm volatile("s_waitcnt vmcnt(0)":"+v"(qr[0]),"+v"(qr[1]),"+v"(qr[2]),"+v"(qr[3])::"memory");
  float mhat=0.f,l_reg=0.f;f32x16 o[2];o[0]=f32x16{};o[1]=f32x16{};f32x16 negm=f32x16{};asm volatile("":"+v"(negm));
    #define CMASK(P0,P1,t) do{}while(0)
  bool resc=false;
  #define START(P0,P1) do{ const float rm=rowmax(P0,P1); resc=false; \
    { const float dl=rm; mhat=fadd_s(mhat,dl); \
      _Pragma("unroll") for(int r=0;r<16;++r){P0[r]=fsub_s(P0[r],dl);P1[r]=fsub_s(P1[r],dl);} \
      _Pragma("unroll") for(int r=0;r<16;++r)negm[r]=-mhat; asm volatile("":"+v"(negm)); } \
    _Pragma("unroll") for(int r=0;r<16;++r)P0[r]=__builtin_amdgcn_exp2f(P0[r]); }while(0)
  #define RESC() do{ if(resc){ asm volatile("s_waitcnt lgkmcnt(0)":::"memory"); \
      _Pragma("unroll") for(int d_=0;d_<2;++d_) _Pragma("unroll") for(int r=0;r<16;++r)o[d_][r]*=wsf[crow(r,hi)]; } }while(0)
  f32x16 pA0,pA1,pB0,pB1;
  int sl_prev=0,sl_cur=0,sl_next=SLOTB;
  #define ROT() do{sl_prev=sl_cur;sl_cur=sl_next;sl_next=(sl_next==(NSLOT-1)*SLOTB)?0:sl_next+SLOTB;}while(0)
  DMA_K(2,2*SLOTB);
  WAIT_BAR(3);
  qkt(pA0,pA1,Kbase,qr,negm,r32,hi);asm volatile("s_nop 15\n\ts_nop 7":"+v"(pA0),"+v"(pA1));CMASK(pA0,pA1,0);
  START(pA0,pA1);
  _Pragma("unroll") for(int r=0;r<16;++r)pA1[r]=__builtin_amdgcn_exp2f(pA1[r]);
  WAIT_BAR(0);
  DMA_K(3,0);DMA_V(1,SLOTB);
  ROT();
  kload8(kf,kp0+sl_cur);
  WAIT_BAR(2);
  s16x4 vlo[8],vhi[8]; u32x4 pw0,pw1,pw2,pw3;
  #define PKW(P,B) cvtpk_s(P[B],P[B+1])
  #define PAF(k) __builtin_bit_cast(bf16x8,pw##k)
  #define VFR(i) (bf16x8){vlo[i][0],vlo[i][1],vlo[i][2],vlo[i][3],vhi[i][0],vhi[i][1],vhi[i][2],vhi[i][3]}
  #define PIN(x) asm volatile("":"+v"(x))
  #define MX3(a,b,c) __builtin_fmaxf(__builtin_fmaxf((a),(b)),(c))
  #define GAPA(MF,A0,A1,A2,A3,W0,W1,PW) do{ MF; sacc+=A0; sacc+=A1; sacc+=A2; sacc+=A3; PIN(sacc); W0; W1; PIN(PW); SBAR(); }while(0)
  #define EX(v) __builtin_amdgcn_exp2f(v)
  #define GAPB(MF,X,B) do{ MF; X[B]=EX(X[B]); X[B+1]=EX(X[B+1]); X[B+2]=EX(X[B+2]); X[B+3]=EX(X[B+3]); PIN(X); SBAR(); }while(0)
  #define VRD(i) do{ vlo[i]=vtr(vp_+(((i)>>2)*4096+((i)&3)*1024)); vhi[i]=vtr(vp_+(((i)>>2)*4096+((i)&3)*1024+512)); }while(0)
  #define KRD(G,j) do{ if(G){ kload2(kf,kp0+sl_next,j); SBAR(); } }while(0)
  #define STEP(C0,C1,P0,P1,t,GK,GV,GL) do{ SBAR(); \
    const lds_cptr vp_=vp0+sl_prev; \
    VRD(0); SBAR(); float sacc=(P0[0]+P0[1]); \
    GAPA(C0=__builtin_amdgcn_mfma_f32_32x32x16_bf16(kf[0],qr[0],negm,0,0,0), P0[2],P0[3],P0[4],P0[5],     pw0[0]=PKW(P0,0), pw0[1]=PKW(P0,2), pw0); \
    VRD(4); SBAR(); GAPA(C1=__builtin_amdgcn_mfma_f32_32x32x16_bf16(kf[1],qr[0],negm,0,0,0), P0[6],P0[7],P0[8],P0[9],     pw0[2]=PKW(P0,4), pw0[3]=PKW(P0,6), pw0); \
    VRD(1); SBAR(); GAPA(C0=__builtin_amdgcn_mfma_f32_32x32x16_bf16(kf[2],qr[1],C0,0,0,0),   P0[10],P0[11],P0[12],P0[13], pw1[0]=PKW(P0,8), pw1[1]=PKW(P0,10), pw1); \
    VRD(5); SBAR(); GAPA(C1=__builtin_amdgcn_mfma_f32_32x32x16_bf16(kf[3],qr[1],C1,0,0,0),   P0[14],P0[15],P1[0],P1[1],   pw1[2]=PKW(P0,12),pw1[3]=PKW(P0,14), pw1); \
    VRD(2); SBAR(); GAPA(C0=__builtin_amdgcn_mfma_f32_32x32x16_bf16(kf[4],qr[2],C0,0,0,0),   P1[2],P1[3],P1[4],P1[5],     pw2[0]=PKW(P1,0), pw2[1]=PKW(P1,2), pw2); \
    VRD(6); SBAR(); GAPA(C1=__builtin_amdgcn_mfma_f32_32x32x16_bf16(kf[5],qr[2],C1,0,0,0),   P1[6],P1[7],P1[8],P1[9],     pw2[2]=PKW(P1,4), pw2[3]=PKW(P1,6), pw2); \
    VRD(3); SBAR(); GAPA(C0=__builtin_amdgcn_mfma_f32_32x32x16_bf16(kf[6],qr[3],C0,0,0,0),   P1[10],P1[11],P1[12],P1[13], pw3[0]=PKW(P1,8), pw3[1]=PKW(P1,10), pw3); \
    VRD(7); SBAR(); GAPA(C1=__builtin_amdgcn_mfma_f32_32x32x16_bf16(kf[7],qr[3],C1,0,0,0),   P1[14],P1[15],0.f,0.f,       pw3[2]=PKW(P1,12),pw3[3]=PKW(P1,14), pw3); \
    l_reg+=sacc; \
    if(GK){DMA_K((t)+3,sl_cur);} if(GV){DMA_V((t)+1,sl_next);} \
    CMASK(C0,C1,t); \
    { float a=MX3(C0[0],C0[1],C1[0]),b=MX3(C0[2],C0[3],C1[1]); a=MX3(a,C1[2],C1[3]); \
      _Pragma("unroll") for(int r=4;r<16;r+=4){a=MX3(a,C0[r],C0[r+1]);b=MX3(b,C0[r+2],C0[r+3]);a=MX3(a,C1[r],C1[r+1]);b=MX3(b,C1[r+2],C1[r+3]);} \
      float rm=__builtin_fmaxf(a,b); { auto rr=__builtin_amdgcn_permlane32_swap(__float_as_uint(rm),__float_as_uint(rm),false,false); rm=__builtin_fmaxf(__uint_as_float(rr[0]),__uint_as_float(rr[1])); } \
      resc=false; \
      if(__builtin_expect(__any(rm>(float)THRL),0)){ const float dl=__builtin_fmaxf(rm,0.f); mhat+=dl; \
        _Pragma("unroll") for(int r=0;r<16;++r){C0[r]-=dl;C1[r]-=dl;} \
        _Pragma("unroll") for(int r=0;r<16;++r)negm[r]=-mhat; asm volatile("":"+v"(negm)); \
        const float f=__builtin_amdgcn_exp2f(-dl); l_reg*=f; if(hi==0)wsf[r32]=f; resc=true; } } \
    SBAR(); \
    GAPB(o[0]=__builtin_amdgcn_mfma_f32_32x32x16_bf16(PAF(0),VFR(0),o[0],0,0,0), C0,0); \
    GAPB(o[1]=__builtin_amdgcn_mfma_f32_32x32x16_bf16(PAF(0),VFR(4),o[1],0,0,0), C0,4); \
    KRD(GL,0); GAPB(o[0]=__builtin_amdgcn_mfma_f32_32x32x16_bf16(PAF(1),VFR(1),o[0],0,0,0), C0,8); \
    KRD(GL,1); GAPB(o[1]=__builtin_amdgcn_mfma_f32_32x32x16_bf16(PAF(1),VFR(5),o[1],0,0,0), C0,12); \
    KRD(GL,2); GAPB(o[0]=__builtin_amdgcn_mfma_f32_32x32x16_bf16(PAF(2),VFR(2),o[0],0,0,0), C1,0); \
    KRD(GL,3); GAPB(o[1]=__builtin_amdgcn_mfma_f32_32x32x16_bf16(PAF(2),VFR(6),o[1],0,0,0), C1,4); \
    GAPB(o[0]=__builtin_amdgcn_mfma_f32_32x32x16_bf16(PAF(3),VFR(3),o[0],0,0,0), C1,8); \
    GAPB(o[1]=__builtin_amdgcn_mfma_f32_32x32x16_bf16(PAF(3),VFR(7),o[1],0,0,0), C1,12); \
    }while(0)
  int t=1;
  #undef CMASK
  #define CMASK(P0,P1,t) do{}while(0)
  for(;t+5<NT;t+=2){
    STEP(pB0,pB1,pA0,pA1,t,true,true,true);     WAIT_BAR(2); RESC(); ROT();
    STEP(pA0,pA1,pB0,pB1,t+1,true,true,true);   WAIT_BAR(2); RESC(); ROT();
  }
  #undef CMASK
  #define CMASK(P0,P1,t) do{}while(0)
  #define ENDW(tt) do{ if((tt)+3<NT){WAIT_BAR(2);} else if((tt)+2<NT){WAIT_BAR(1);} else {WAIT_BAR(0);} }while(0)
  for(;t+1<NT;t+=2){
    STEP(pB0,pB1,pA0,pA1,t,(t+3<NT),(t+1<NT),(t+1<NT));       ENDW(t);   RESC(); ROT();
    STEP(pA0,pA1,pB0,pB1,t+1,(t+4<NT),(t+2<NT),(t+2<NT));     ENDW(t+1); RESC(); ROT();
  }
  STEP(pB0,pB1,pA0,pA1,NT-1,false,false,false); RESC();
  { float sacc=pB0[0]+pB0[1]; _Pragma("unroll") for(int r=2;r<16;++r)sacc+=pB0[r]; _Pragma("unroll") for(int r=0;r<16;++r)sacc+=pB1[r]; l_reg+=sacc;
    pw0=(u32x4){PKW(pB0,0),PKW(pB0,2),PKW(pB0,4),PKW(pB0,6)};pw1=(u32x4){PKW(pB0,8),PKW(pB0,10),PKW(pB0,12),PKW(pB0,14)};pw2=(u32x4){PKW(pB1,0),PKW(pB1,2),PKW(pB1,4),PKW(pB1,6)};pw3=(u32x4){PKW(pB1,8),PKW(pB1,10),PKW(pB1,12),PKW(pB1,14)};
    SBAR(); pv(o,vb0+sl_cur,PAF(0),PAF(1),PAF(2),PAF(3)); }
  #undef PKW
  #undef PAF
  #undef VFR
  #undef PIN
  #undef MX3
  #undef GAPA
  #undef GAPB
  #undef EX
  #undef VRD
  #undef KRD
  #undef STEP
  #undef ENDW
  {auto rr=__builtin_amdgcn_permlane32_swap(__float_as_uint(l_reg),__float_as_uint(l_reg),false,false);l_reg=__uint_as_float(rr[0])+__uint_as_float(rr[1]);}
  if(hi==0)wsf[32+r32]=l_reg;asm volatile("s_waitcnt lgkmcnt(0)":::"memory");
  float rli[16];
  #pragma unroll
  for(int r=0;r<16;++r)rli[r]=__builtin_amdgcn_rcpf(wsf[32+crow(r,hi)]);
    { bf16*stg=(bf16*)(shm+LDS_OST)+wid*2048;
    #pragma unroll
    for(int r=0;r<16;++r){const int orow=crow(r,hi);
      #pragma unroll
      for(int d0=0;d0<2;++d0)stg[orow*64+d0*32+r32]=__float2bfloat16(o[d0][r]*rli[r]);}
    asm volatile("s_waitcnt lgkmcnt(0)":::"memory");
    #pragma unroll
    for(int i=0;i<4;++i){const int row=i*8+(lane>>3),ch=lane&7; const u32x4 v=*(const u32x4*)(stg+row*64+ch*8);
      ATTN_STORE16((char*)O+pg8::img_off((int)(rowbase+q0+wid*QBLK)+row,h*D+ch*8,DM/64),v);} }
  asm volatile("s_waitcnt lgkmcnt(0)\n\ts_barrier":::"memory");
  #undef DMA_K
  #undef DMA_V
  #undef CMASK
  #undef START
  #undef RESC
  #undef ROT
}
constexpr int ATTN_LDS_BYTES=LDS_BYTES;
constexpr int N_NSLOT=4, N_LDS_K=0, N_LDS_V=N_NSLOT*SLOTB, N_LDS_WS=2*N_NSLOT*SLOTB, N_LDS_OST=N_LDS_WS+NW*64*4, NAT_BIAS_OFF=N_LDS_OST+NW*4096;
__device__ __forceinline__ void qkt32(f32x16&p0,const char*Kw,const bf16x8*qr,const f32x16&c0,int r32,int hi){
  const char*kb=Kw+hi*1024+r32*16;
  #pragma unroll
  for(int d0=0;d0<4;++d0){ const bf16x8 b0=*reinterpret_cast<const bf16x8*>(kb+d0*2048);
    if(d0==0)p0=__builtin_amdgcn_mfma_f32_32x32x16_bf16(b0,qr[0],c0,0,0,0); else p0=__builtin_amdgcn_mfma_f32_32x32x16_bf16(b0,qr[d0],p0,0,0,0);}
}
__device__ __forceinline__ void pv32(f32x16*o,int vb,bf16x8 pa0,bf16x8 pa1){
  #pragma unroll
  for(int d0=0;d0<2;++d0){s16x4 lo[2],hi[2];
    #pragma unroll
    for(int ks=0;ks<2;++ks){
      asm volatile("ds_read_b64_tr_b16 %0,%1 offset:%c2":"=&v"(lo[ks]):"v"(vb),"i"(d0*4096+ks*1024):"memory");
      asm volatile("ds_read_b64_tr_b16 %0,%1 offset:%c2":"=&v"(hi[ks]):"v"(vb),"i"(d0*4096+ks*1024+512):"memory");}
    asm volatile("s_waitcnt lgkmcnt(0)":::"memory");SBAR();
    #define PK(k) (bf16x8){lo[k][0],lo[k][1],lo[k][2],lo[k][3],hi[k][0],hi[k][1],hi[k][2],hi[k][3]}
    o[d0]=__builtin_amdgcn_mfma_f32_32x32x16_bf16(pa0,PK(0),o[d0],0,0,0);
    o[d0]=__builtin_amdgcn_mfma_f32_32x32x16_bf16(pa1,PK(1),o[d0],0,0,0);
    #undef PK
  }
}
template<int KP> __device__ __forceinline__ void natten_unit(int b,int h,int j,const bf16*Q,const bf16*__restrict__ K,const bf16*__restrict__ V,bf16*O,const float*__restrict__ bias_h,char*shm){
  int tid_=threadIdx.x; asm volatile("":"+v"(tid_));
  const int tid=tid_,lane=tid&63,r32=lane&31,hi=lane>>5; const int wid=__builtin_amdgcn_readfirstlane(tid>>6);
  const long rowbase=(long)b*SEQ;
  const bf16*Kh=K+((long)b*KP+h)*(long)(NT_IMG*4096),*Vh=V+((long)b*KP+h)*(long)(NT_IMG*4096);
  const unsigned lds0=(unsigned)(uintptr_t)shm;
  float*wsf=(float*)(shm+N_LDS_WS)+wid*64;
  float*biasL=(float*)(shm+NAT_BIAS_OFF);
  const bf16*ksrc=Kh+wid*512+lane*8;
  const bf16*vsrc=Vh+wid*512+lane*8;
  const unsigned kdst=lds0+N_LDS_K+wid*1024, vdst=lds0+N_LDS_V+wid*1024;
  #define DMA_K(t,slot) glds16(ksrc+(long)(t)*4096,(unsigned)__builtin_amdgcn_readfirstlane(kdst+(slot)))
  #define DMA_V(t,slot) glds16(vsrc+(long)(t)*4096,(unsigned)__builtin_amdgcn_readfirstlane(vdst+(slot)))
  const int g=wid&3, R0=4*j+2*(wid>>2);
  const int kb=min(max(16*g-8,0),32);
  const int vb0=(int)(lds0+N_LDS_V)+((lane>>4)&1)*32+(lane&3)*8+(4*hi+((lane&15)>>2))*64+kb*64;
  const char*Kbase=shm+N_LDS_K+kb*16;
  const int wlo=min(max(R0-4,0),120), whi=min(max(R0-3,0),120)+7;
  const int kr_lo=min(max(4*j-4,0),120), kr_hi=min(max(4*j-1,0),120)+7, nt=kr_hi-kr_lo+1;
  const int qrow=R0+(r32>>4), qc=16*g+(r32&15);
  const int r0l=min(max(qrow-4,0),120), c0=min(max(qc-8,0),48);
  DMA_K(kr_lo,0);DMA_V(kr_lo,0);DMA_K(kr_lo+1,SLOTB);DMA_V(kr_lo+1,SLOTB);
  const bf16*Qw=Q+(rowbase+qrow*64+qc)*DM+h*D;
  bf16x8 qr[4];
  #pragma unroll
  for(int d0=0;d0<4;++d0)qr[d0]=*reinterpret_cast<const bf16x8*>(&Qw[d0*16+hi*8]);
  { const int i=tid; if(i<15*31){ const float bv=bias_h[i]; biasL[i]=bv*1.4426950408889634f; } }
  asm volatile("s_waitcnt vmcnt(0)":"+v"(qr[0]),"+v"(qr[1]),"+v"(qr[2]),"+v"(qr[3])::"memory");
  float m_run=-1e4f,l_reg=0.f;f32x16 o[2];o[0]=f32x16{};o[1]=f32x16{};
  const f32x16 zero16=f32x16{};
  #define NAT_TILE(kr,slot) do{ \
    if(kr>=wlo&&kr<=whi){ \
      f32x16 p0; \
      qkt32(p0,Kbase+slot,qr,zero16,r32,hi); \
      const float*brow=biasL+(kr-qrow+7)*31+(15-qc)+kb; \
      const bool rv=(kr>=r0l)&&(kr<r0l+8); \
      float bb0[16]; \
      _Pragma("unroll") \
      for(int r=0;r<16;++r)bb0[r]=brow[crow(r,hi)]; \
      _Pragma("unroll") \
      for(int r=0;r<16;r+=8)asm volatile("":"+v"(bb0[r]),"+v"(bb0[r+1]),"+v"(bb0[r+2]),"+v"(bb0[r+3]),"+v"(bb0[r+4]),"+v"(bb0[r+5]),"+v"(bb0[r+6]),"+v"(bb0[r+7])); \
      _Pragma("unroll") \
      for(int r=0;r<16;++r){ const int kc=kb+crow(r,hi); p0[r]=(rv&&((unsigned)(kc-c0)<16u))?p0[r]+bb0[r]:-1e30f; } \
      float rm=fmaxf(p0[0],p0[1]); \
      _Pragma("unroll") \
      for(int r=2;r<16;++r)rm=fmaxf(rm,p0[r]); \
      rm=fmaxf(rm,__shfl_xor(rm,32)); \
      if(__any(rm>m_run+8.f)){ \
        const float mn=fmaxf(m_run,rm); const float f=__builtin_amdgcn_exp2f(m_run-mn); m_run=mn; l_reg*=f; \
        if(hi==0)wsf[r32]=f; \
        asm volatile("s_waitcnt lgkmcnt(0)":::"memory"); \
        _Pragma("unroll") \
        for(int r=0;r<16;++r){ const float fr_=wsf[crow(r,hi)]; o[0][r]*=fr_; o[1][r]*=fr_; } \
      } \
      float ls=0.f; \
      _Pragma("unroll") \
      for(int r=0;r<16;++r){ p0[r]=__builtin_amdgcn_exp2f(p0[r]-m_run); ls+=p0[r]; } \
      l_reg+=ls; \
      u32x4 pw0,pw1; \
      pw0=(u32x4){cvtpk_s(p0[0],p0[1]),cvtpk_s(p0[2],p0[3]),cvtpk_s(p0[4],p0[5]),cvtpk_s(p0[6],p0[7])};pw1=(u32x4){cvtpk_s(p0[8],p0[9]),cvtpk_s(p0[10],p0[11]),cvtpk_s(p0[12],p0[13]),cvtpk_s(p0[14],p0[15])}; \
      SBAR(); pv32(o,vb0+slot,__builtin_bit_cast(bf16x8,pw0),__builtin_bit_cast(bf16x8,pw1)); \
    } \
  }while(0)
  for(int t=0;t<nt;t+=2){
    WAIT_BAR(0);
    if(t+2<nt){ DMA_K(kr_lo+t+2,((t+2)&3)*SLOTB); DMA_V(kr_lo+t+2,((t+2)&3)*SLOTB); }
    if(t+3<nt){ DMA_K(kr_lo+t+3,((t+3)&3)*SLOTB); DMA_V(kr_lo+t+3,((t+3)&3)*SLOTB); }
    NAT_TILE(kr_lo+t,(t&3)*SLOTB);
    if(t+1<nt) NAT_TILE(kr_lo+t+1,((t+1)&3)*SLOTB);
  }
  #undef NAT_TILE
  l_reg+=__shfl_xor(l_reg,32);
  if(hi==0)wsf[32+r32]=l_reg;asm volatile("s_waitcnt lgkmcnt(0)":::"memory");
  float rli[16];
  #pragma unroll
  for(int r=0;r<16;++r)rli[r]=__builtin_amdgcn_rcpf(wsf[32+crow(r,hi)]);
  { bf16*stg=(bf16*)(shm+N_LDS_OST)+wid*2048;
    #pragma unroll
    for(int r=0;r<16;++r){const int orow=crow(r,hi);
      #pragma unroll
      for(int d0=0;d0<2;++d0)stg[orow*64+d0*32+r32]=__float2bfloat16(o[d0][r]*rli[r]);}
    asm volatile("s_waitcnt lgkmcnt(0)":::"memory");
    #pragma unroll
    for(int i=0;i<4;++i){const int row=i*8+(lane>>3),ch=lane&7; const u32x4 v=*(const u32x4*)(stg+row*64+ch*8);
      ATTN_STORE16((char*)O+pg8::img_off((int)rowbase+(R0+(row>>4))*64+16*g+(row&15),h*D+ch*8,DM/64),v);} }
  asm volatile("s_waitcnt vmcnt(0) lgkmcnt(0)\n\ts_barrier":::"memory");
  #undef DMA_K
  #undef DMA_V
}
#undef SBAR
#undef WAIT_BAR
}
namespace pg8 {
constexpr float C2Q = 0.125f * 1.4426950408889634f;
constexpr float NEPS = 1e-6f;
__device__ __forceinline__ u32x4 pack8(const f32x4 a, const f32x4 b) { u32x4 w; w.x = cvt_pk_bf16(a[0], a[1]); w.y = cvt_pk_bf16(a[2], a[3]); w.z = cvt_pk_bf16(b[0], b[1]); w.w = cvt_pk_bf16(b[2], b[3]); return w; }
struct Carry8 { float s[8]; };
struct CarryNone {};
__device__ __forceinline__ void zero_acc(f32x4 (&acc)[2][2][4][2]) {
#pragma unroll
    for (int a = 0; a < 2; ++a)
#pragma unroll
        for (int b = 0; b < 2; ++b)
#pragma unroll
            for (int m = 0; m < 4; ++m)
#pragma unroll
                for (int n = 0; n < 2; ++n) acc[a][b][m][n] = (f32x4){0.f, 0.f, 0.f, 0.f};
}
__device__ __forceinline__ void load_ss8(Carry8& c, const float* ss, const Unit& u, int wr, int fr) {
#pragma unroll
    for (int ai = 0; ai < 2; ++ai)
#pragma unroll
        for (int m = 0; m < 4; ++m) c.s[ai * 4 + m] = ss[u.pm * BM + ai * HALF + wr * 64 + m * 16 + fr];
}
__device__ __forceinline__ float dot4(const f32x4 a) { return (a[0] * a[0] + a[1] * a[1]) + (a[2] * a[2] + a[3] * a[3]); }
template <int MODE> struct EpiQKV {
    static constexpr bool PERM = true, AFTER_DRAIN = false;
    typedef Carry8 Carry;
    __device__ __forceinline__ void init(f32x4 (&acc)[2][2][4][2], Carry& c, const Unit& u, int wr, int wc, int fr, int fq) const { zero_acc(acc); load_ss8(c, ss, u, wr, fr); }
    bf16_t* Q; long kofs, vofs; const float* ss; const float* rope;
    __device__ __forceinline__ void operator()(const f32x4 (&acc)[2][2][4][2], const Carry& cy, const Unit& u, int wr, int wc, int fr, int fq) const {
        int kind, headcol, head;
        constexpr int NHKV = (MODE == 0) ? 4 : 16;
        if (MODE == 0) { kind = u.pn < 4 ? 0 : u.pn - 3; headcol = (kind == 0 ? u.pn * 256 : 0) + wc * 64; head = wc; }
        else { kind = u.pn >> 2; headcol = (u.pn & 3) * 256 + wc * 64; head = (u.pn & 3) * 4 + wc; }
        bf16_t* dst = Q + (kind == 0 ? 0l : (kind == 1 ? kofs : vofs));
        const int cofs = headcol + 8 * fq;
        const int kvlane = (kind == 1) ? fq * 512 + fr * 8 : fr * 32 + fq * 8;
        const bool rot = (MODE == 0) && kind < 2;
        f32x4 g[2][2];
#pragma unroll
        for (int bj = 0; bj < 2; ++bj)
#pragma unroll
            for (int n = 0; n < 2; ++n) g[bj][n] = rot ? *(const f32x4*)(rope + 4096 + (kind == 0 ? 0 : 64) + 32 * bj + 8 * fq + 4 * n) : (f32x4){1.f, 1.f, 1.f, 1.f};
        const float outs = (kind == 0) ? C2Q : 1.f;
        const float sgn = (fq < 2) ? -1.f : 1.f;
#pragma unroll
        for (int ai = 0; ai < 2; ++ai)
#pragma unroll
            for (int m = 0; m < 4; ++m) {
                const int row = u.pm * BM + ai * HALF + wr * 64 + m * 16 + fr;
                const float rs = __builtin_amdgcn_rsqf(cy.s[ai * 4 + m] * (1.f / 1024.f) + NEPS);
                f32x4 v[2][2];
#pragma unroll
                for (int bj = 0; bj < 2; ++bj)
#pragma unroll
                    for (int n = 0; n < 2; ++n) v[bj][n] = acc[ai][bj][m][n] * rs;
                if (rot) {
                    float hs = (dot4(v[0][0]) + dot4(v[0][1])) + (dot4(v[1][0]) + dot4(v[1][1]));
                    hs += __shfl_xor(hs, 16); hs += __shfl_xor(hs, 32);
                    const float rn = __builtin_amdgcn_rsqf(hs * (1.f / 64.f) + NEPS);
                    const int t = row & 8191;
#pragma unroll
                    for (int bj = 0; bj < 2; ++bj) {
                        const int pos = bj ? (t & 63) : (t >> 6);
                        const float* rp = rope + pos * 32 + 8 * (fq & 1);
#pragma unroll
                        for (int n = 0; n < 2; ++n) {
                            const f32x4 c4 = *(const f32x4*)(rp + 4 * n); const f32x4 s4 = *(const f32x4*)(rp + 16 + 4 * n) * sgn;
                            const f32x4 x = v[bj][n] * rn * g[bj][n];
                            f32x4 p; p[0] = __shfl_xor(x[0], 32); p[1] = __shfl_xor(x[1], 32); p[2] = __shfl_xor(x[2], 32); p[3] = __shfl_xor(x[3], 32);
                            v[bj][n] = x * c4 + p * s4;
                        }
                    }
                }
#pragma unroll
                for (int bj = 0; bj < 2; ++bj) {
                    const u32x4 w8 = pack8(v[bj][0] * outs, v[bj][1] * outs);
                    if (kind == 0) *(u32x4*)(dst + (size_t)row * 1024 + cofs + 32 * bj) = w8;
                    else {
                        const int rowblk = u.pm * 4 + ai * 2 + wr;
                        const size_t img = ((size_t)((rowblk >> 7) * NHKV + head) * 128 + (rowblk & 127)) * 4096;
                        *(u32x4*)(dst + img + kvlane + m * (kind == 1 ? 128 : 512) + bj * 2048) = w8;
                    }
                }
            }
    }
};
constexpr int U_HALF_IMGS = 65;
template <bool STORE = true> struct EpiRelu2T {
    static constexpr bool PERM = true, AFTER_DRAIN = false;
    bf16_t* U; const float* ss;
    typedef Carry8 Carry;
    __device__ __forceinline__ void init(f32x4 (&acc)[2][2][4][2], Carry& c, const Unit& u, int wr, int wc, int fr, int fq) const { zero_acc(acc); load_ss8(c, ss, u, wr, fr); }
    __device__ __forceinline__ void operator()(const f32x4 (&acc)[2][2][4][2], const Carry& cy, const Unit& u, int wr, int wc, int fr, int fq) const {
#pragma unroll
        for (int ai = 0; ai < 2; ++ai)
#pragma unroll
            for (int m = 0; m < 4; ++m) {
                const int row = u.pm * BM + ai * HALF + wr * 64 + m * 16 + fr;
                const float rs = __builtin_amdgcn_rsqf(cy.s[ai * 4 + m] * (1.f / 1024.f) + NEPS);
                char* rowp = (char*)U + ((size_t)(u.pm * 2 + ai) * U_HALF_IMGS + u.pn * 4 + wc) * 16384 + (wr * 8 + 2 * m) * 1024 + ((fr * 64 + 16 * fq) ^ ((fr & 8) << 2));
#pragma unroll
                for (int bj = 0; bj < 2; ++bj) {
                    f32x4 a = acc[ai][bj][m][0] * rs, b = acc[ai][bj][m][1] * rs;
#pragma unroll
                    for (int e = 0; e < 4; ++e) { a[e] = fmaxf(a[e], 0.f); b[e] = fmaxf(b[e], 0.f); }
                    if (STORE || a[0] == 1.2345e30f) __builtin_nontemporal_store(pack8(a * a, b * b), (u32x4*)(rowp + bj * 1024));
                }
            }
    }
};
struct EpiRes {
    static constexpr bool PERM = true, AFTER_DRAIN = false;
    bf16_t* xb; float* ssout;
    typedef CarryNone Carry;
    __device__ __forceinline__ void init(f32x4 (&acc)[2][2][4][2], Carry&, const Unit& u, int wr, int wc, int fr, int fq) const { zero_acc(acc); }
    __device__ __forceinline__ void operator()(const f32x4 (&acc)[2][2][4][2], const Carry&, const Unit& u, int wr, int wc, int fr, int fq) const {
#pragma unroll
        for (int ai = 0; ai < 2; ++ai)
#pragma unroll
            for (int m = 0; m < 4; ++m) {
                const int row = u.pm * BM + ai * HALF + wr * 64 + m * 16 + fr;
                char* rowp = (char*)xb + ((size_t)(u.pm * 2 + ai) * 16 + u.pn * 4 + wc) * 16384 + (wr * 8 + 2 * m) * 1024 + ((fr * 64 + 16 * fq) ^ ((fr & 8) << 2));
                float part = 0.f;
#pragma unroll
                for (int bj = 0; bj < 2; ++bj) {
                    const u32x4 w = *(const u32x4*)(rowp + bj * 1024);
                    const f32x4 b0 = {__uint_as_float(w.x << 16), __uint_as_float(w.x & 0xffff0000u), __uint_as_float(w.y << 16), __uint_as_float(w.y & 0xffff0000u)};
                    const f32x4 b1 = {__uint_as_float(w.z << 16), __uint_as_float(w.z & 0xffff0000u), __uint_as_float(w.w << 16), __uint_as_float(w.w & 0xffff0000u)};
                    const f32x4 o0 = b0 + acc[ai][bj][m][0], o1 = b1 + acc[ai][bj][m][1];
                    *(u32x4*)(rowp + bj * 1024) = pack8(o0, o1);
                    part += dot4(o0) + dot4(o1);
                }
                part += __shfl_xor(part, 16); part += __shfl_xor(part, 32);
                if (fq == 0) unsafeAtomicAdd(ssout + row, part);
            }
    }
};
typedef EpiRelu2T<true> EpiRelu2;
}
namespace cg = cooperative_groups;
constexpr int NWAVES = 8;
constexpr int DM_ = 1024, SEQ_ = 8192, NB_ = 6, M_ = NB_ * SEQ_, FF_ = 4096, NQKV_A = 1536, NQKV_B = 3072, M_PROMPT = 4 * SEQ_;
constexpr size_t MiB = 1u << 20;
constexpr size_t WS_SS = 0;
constexpr size_t SS_STRIDE = (size_t)M_ * 4;
constexpr size_t WS_ROPE = 5 * SS_STRIDE;
constexpr size_t WS_WIN = 1 * MiB, WS_WOUT = 9 * MiB;
constexpr size_t WS_XB = 17 * MiB;
constexpr size_t WS_U = 113 * MiB;
constexpr size_t WS_Q = 113 * MiB, WS_KA = 209 * MiB, WS_VA = 233 * MiB, WS_KB = 209 * MiB, WS_VB = 305 * MiB;
constexpr size_t WS_END = 504 * MiB;
constexpr int RING_BYTES = 131072, LDS_TOTAL = 147456, LDS_MISC = 131072;
constexpr size_t WS_BAR = 1024000;

#define GAS __attribute__((address_space(1)))
#define LAS __attribute__((address_space(3)))
typedef unsigned short bf16;
typedef unsigned v4u __attribute__((ext_vector_type(4)));
typedef float f32x4 __attribute__((ext_vector_type(4)));
__device__ __forceinline__ unsigned f2bf(float f) { unsigned u = __builtin_bit_cast(unsigned, f); return (u + 0x7fffu + ((u >> 16) & 1u)) >> 16; }
__device__ __forceinline__ unsigned pk2(float lo, float hi) { return f2bf(lo) | (f2bf(hi) << 16); }
#define RLX_AGENT __ATOMIC_RELAXED, __HIP_MEMORY_SCOPE_AGENT
#define XB_TMO      128
#define XB_XCNT(j)  (256  + 64 * (j))
#define XB_XSUB(j)  (1280 + 64 * (j))
#define XB_XGEN(j)  (2304 + 64 * (j))
#define XB_TOP      3328
#define XB_TOPGEN   3392
#define XCD_BAR_WORDS 3456
#define XB_SPIN_CAP (1u << 18)

__device__ __forceinline__ unsigned xb_ld(unsigned* p)              { return __hip_atomic_load(p, __ATOMIC_RELAXED, __HIP_MEMORY_SCOPE_AGENT); }
__device__ __forceinline__ unsigned xb_add(unsigned* p, unsigned v) { return __hip_atomic_fetch_add(p, v, __ATOMIC_RELAXED, __HIP_MEMORY_SCOPE_AGENT); }
__device__ __forceinline__ unsigned xb_xcc_id() { return (unsigned)__builtin_amdgcn_s_getreg((3 << 11) | 20) & 0xFu; }
#define XB_SPIN(cond, bar) do { unsigned _sp = 0; while (cond) { __builtin_amdgcn_s_sleep(1); \
    if ((++_sp & 255u) == 0u) { if (xb_ld(&(bar)[XB_TMO])) break; if (_sp > XB_SPIN_CAP) { atomicAdd(&(bar)[XB_TMO], 1u); break; } } } } while (0)

struct XcdBarrier {
    unsigned* bar; unsigned x;
    volatile LAS unsigned* st;
};

__device__ __forceinline__ XcdBarrier xcd_barrier_post(unsigned* bar, volatile LAS unsigned* st) {
    XcdBarrier b; b.bar = bar; b.x = xb_xcc_id(); b.st = st;
    if (threadIdx.x == 0) (void)xb_add(&bar[XB_XCNT(b.x)], 1u);
    return b;
}
__device__ __forceinline__ void xcd_barrier_complete(unsigned* bar, unsigned x, unsigned& nloc, unsigned& nx) {
    const unsigned G = gridDim.x * gridDim.y * gridDim.z;
    unsigned sum, cnt, mine, sp = 0u;
    for (;;) {
        sum = 0u; cnt = 0u; mine = 0u;
#pragma unroll
        for (unsigned j = 0; j < 16; ++j) { const unsigned c = xb_ld(&bar[XB_XCNT(j)]); sum += c; cnt += (c > 0u) ? 1u : 0u; mine = (j == x) ? c : mine; }
        if (sum == G) break;
        __builtin_amdgcn_s_sleep(1);
        if ((++sp & 255u) == 0u) { if (xb_ld(&bar[XB_TMO])) break; if (sp > XB_SPIN_CAP) { atomicAdd(&bar[XB_TMO], 1u); break; } }
    }
    nloc = mine > 0u ? mine : 1u; nx = cnt > 0u ? cnt : 1u;
}

__device__ __forceinline__ void xcd_barrier(const XcdBarrier& b) {
    asm volatile("s_waitcnt vmcnt(0)" ::: "memory");
    __syncthreads();
    if (threadIdx.x == 0) {
        unsigned* bar = b.bar;
        __builtin_amdgcn_s_waitcnt(0);
        unsigned nloc = b.st[0], nx = b.st[1];
        if (nloc == 0u) { xcd_barrier_complete(bar, b.x, nloc, nx); b.st[0] = nloc; b.st[1] = nx; }
        const unsigned old = xb_add(&bar[XB_XSUB(b.x)], 1u);
        const unsigned gen = old / nloc;
        if (old + 1u == (gen + 1u) * nloc) {
            __builtin_amdgcn_fence(__ATOMIC_RELEASE, "agent");
            asm volatile("s_waitcnt vmcnt(0)" ::: "memory");
            const unsigned og = xb_add(&bar[XB_TOP], 1u);
            const unsigned tg = og / nx;
            if (og + 1u == (tg + 1u) * nx) xb_add(&bar[XB_TOPGEN], 1u);
            else XB_SPIN(xb_ld(&bar[XB_TOPGEN]) == tg, bar);
            __builtin_amdgcn_fence(__ATOMIC_ACQUIRE, "agent");
            xb_add(&bar[XB_XGEN(b.x)], 1u);
            asm volatile("s_waitcnt vmcnt(0)" ::: "memory");
        } else {
            XB_SPIN(xb_ld(&bar[XB_XGEN(b.x)]) == gen, bar);
            __builtin_amdgcn_fence(__ATOMIC_ACQUIRE, "agent");
            asm volatile("s_waitcnt vmcnt(0)" ::: "memory");
        }
    }
    __syncthreads();
}
__device__ __forceinline__ float wave_sum(float v) {
#pragma unroll
    for (int o = 1; o < 64; o <<= 1) v += __shfl_xor(v, o);
    return v;
}
__device__ __forceinline__ void transpose_item(const float* __restrict__ W, int K, int N, const float* __restrict__ gain, bf16* WT, bool permute, float* scr, int item, int lane) {
    const int nblk = N / 32, kb = item / nblk, nb = item % nblk, k0 = 64 * kb, n0 = 32 * nb;
    {
        f32x4 wv[8];
#pragma unroll
        for (int i = 0; i < 8; ++i) wv[i] = *(const f32x4*)(W + (size_t)(k0 + 8 * i + (lane >> 3)) * N + n0 + 4 * (lane & 7));
#pragma unroll
        for (int i = 0; i < 8; ++i) { const int kk = 8 * i + (lane >> 3); const float gk = gain ? gain[k0 + kk] : 1.f; float* d = scr + kk * 33 + 4 * (lane & 7);
            d[0] = wv[i].x * gk; d[1] = wv[i].y * gk; d[2] = wv[i].z * gk; d[3] = wv[i].w * gk; }
    }
    asm volatile("s_waitcnt lgkmcnt(0)" ::: "memory");
    const int idx = (n0 >> 5) & 7; const int n0d = permute ? ((n0 & ~255) + ((((idx & 1) << 2) | (idx >> 1)) << 5)) : n0;
    const int c = lane & 7;
#pragma unroll
    for (int j = 0; j < 4; ++j) { const int n = (lane >> 3) + 8 * j; const float* s = scr + (8 * c) * 33 + n;
        v4u o; o.x = pk2(s[0 * 33], s[1 * 33]); o.y = pk2(s[2 * 33], s[3 * 33]); o.z = pk2(s[4 * 33], s[5 * 33]); o.w = pk2(s[6 * 33], s[7 * 33]);
        const int ng = n0d + n, nl = ng & 127, x = nl & 31, R = (nl & ~31) + 16 * ((x >> 2) & 1) + 4 * (x >> 3) + (x & 3);
        *(v4u*)((char*)WT + ((size_t)(ng >> 7) * (K / 64) + kb) * 16384 + pg8::lds_byte(R, 8 * c)) = o; }
    asm volatile("s_waitcnt lgkmcnt(0)" ::: "memory");
}
struct WJob { const float* W; int K, N; const float* gain; bf16* WT; int permute; };
__device__ __forceinline__ void convert_weights(const WJob* jobs, int njobs, float* scr, int gw, int NGW, int lane);

struct Args { const float* in[14]; float* out; unsigned char* ws; };

__global__ void __launch_bounds__(NWAVES * 64, 2) mk_fwd(Args args) {
    extern __shared__ __attribute__((aligned(16))) unsigned char lds[];
    cg::grid_group grid = cg::this_grid();
    const int tid = threadIdx.x, lane = tid & 63, wave = __builtin_amdgcn_readfirstlane(tid >> 6);
    const int G = gridDim.x, bx = blockIdx.x;
    const int gw = bx * NWAVES + wave, NGW = G * NWAVES;
    unsigned char* ws = args.ws;
    const float* xp = args.in[0]; const float* xs = args.in[1];
    const float* norm_mix = args.in[2]; const float* norm_mlp = args.in[3]; const float* norm_final = args.in[4];
    const float* a_w_qkv = args.in[5]; const float* a_q_norm = args.in[6]; const float* a_k_norm = args.in[7]; const float* a_w_o = args.in[8];
    const float* b_w_qkv = args.in[9]; const float* b_rel_bias = args.in[10]; const float* b_w_o = args.in[11];
    const float* mlp_w_in = args.in[12]; const float* mlp_w_out = args.in[13];
    float* out = args.out;
    float* ss = (float*)(ws + WS_SS); float* rope = (float*)(ws + WS_ROPE);
    bf16* Win_t = (bf16*)(ws + WS_WIN); bf16* Wout_t = (bf16*)(ws + WS_WOUT);
    bf16* Win1_t = (bf16*)out; bf16* Wout1_t = (bf16*)out + (size_t)FF_ * DM_;
    bf16* Ob = (bf16*)((unsigned char*)out + 16 * MiB);
    bf16* XB = (bf16*)(ws + WS_XB); bf16* U = (bf16*)(ws + WS_U);
    bf16* Qb = (bf16*)(ws + WS_Q); bf16* KA = (bf16*)(ws + WS_KA); bf16* VA = (bf16*)(ws + WS_VA); bf16* KB = (bf16*)(ws + WS_KB); bf16* VB = (bf16*)(ws + WS_VB);
    unsigned char* outb = (unsigned char*)out;
    bf16* WqkvA_t = (bf16*)(outb + 112 * MiB); bf16* WoA_t = (bf16*)(outb + 115 * MiB); bf16* WqkvB_t = (bf16*)(outb + 117 * MiB); bf16* WoB_t = (bf16*)(outb + 123 * MiB);
    LAS unsigned char* ldsp = (LAS unsigned char*)lds;
    float* scr = (float*)(lds + wave * 16384);

#define CONVERT(Wp, Kk, Nn, gainp, WTp, perm) do { const int nit_ = ((Kk) / 64) * ((Nn) / 32); for (int it_ = gw; it_ < nit_; it_ += NGW) transpose_item((Wp), (Kk), (Nn), (gainp), (WTp), (perm), scr, it_, lane); } while (0)

    if (tid < 2) ((volatile LAS unsigned*)(ldsp + LDS_MISC))[tid] = 0u;
    __syncthreads();
#ifdef PROBE_DUP_P0
    for (int rep_ = 0; rep_ < 2; ++rep_)
#endif
    {
        int tid0_ = threadIdx.x; asm volatile("" : "+v"(tid0_)); const int tid = tid0_, lane = tid0_ & 63;
        if (bx == 0) for (int i = tid; i < XCD_BAR_WORDS; i += NWAVES * 64) ((unsigned*)(ws + WS_BAR))[i] = 0u;
        CONVERT(a_w_qkv, DM_, NQKV_A, norm_mix, WqkvA_t, true);
        CONVERT(a_w_o, DM_, DM_, (const float*)nullptr, WoA_t, true);
        CONVERT(mlp_w_in, DM_, FF_, norm_mlp, Win_t, true);
        CONVERT(mlp_w_out, FF_, DM_, (const float*)nullptr, Wout_t, true);
        for (int m0 = gw; m0 < M_; m0 += 2 * NGW) {
            f32x4 v[2][4];
#pragma unroll
            for (int q = 0; q < 2; ++q) { const int m = m0 + q * NGW;
                const float* xrow = (m < M_PROMPT) ? xp + (size_t)m * DM_ : xs + (size_t)(m - M_PROMPT) * DM_;
                const f32x4* xr = (const f32x4*)xrow;
#pragma unroll
                for (int j = 0; j < 2; ++j) { v[q][2 * j] = xr[2 * (lane + 64 * j)]; v[q][2 * j + 1] = xr[2 * (lane + 64 * j) + 1]; } }
#pragma unroll
            for (int q = 0; q < 2; ++q) { const int m = m0 + q * NGW; float s = 0.f;
#pragma unroll
                for (int j = 0; j < 4; ++j) s += (v[q][j].x * v[q][j].x + v[q][j].y * v[q][j].y) + (v[q][j].z * v[q][j].z + v[q][j].w * v[q][j].w);
                s = wave_sum(s);
#pragma unroll
                for (int j = 0; j < 2; ++j) { v4u o; o.x = pk2(v[q][2 * j].x, v[q][2 * j].y); o.y = pk2(v[q][2 * j].z, v[q][2 * j].w); o.z = pk2(v[q][2 * j + 1].x, v[q][2 * j + 1].y); o.w = pk2(v[q][2 * j + 1].z, v[q][2 * j + 1].w);
                    *(v4u*)((char*)XB + pg8::img_off(m, 8 * (lane + 64 * j), DM_ / 64)) = o; }
                if (lane == 0) ss[m] = s; }
        }
        for (int i = bx * (NWAVES * 64) + tid; i < 4 * M_; i += G * NWAVES * 64) ss[M_ + i] = 0.f;
        for (int i = bx * (NWAVES * 64) + tid; i < 128 * 16; i += G * NWAVES * 64) {
            const int pos = i >> 4, fi = i & 15;
            const float inv = exp2f(-(float)fi * (13.287712379549449f / 16.f));
            const float ang = (float)pos * inv;
            const float k = rintf(ang * 0.15915494309189535f);
            float r = fmaf(-k, 6.2831854820251465f, ang); r = fmaf(-k, -1.7484555e-7f, r);
            const float xr = r * 0.15915494309189535f;
            rope[pos * 32 + fi] = __builtin_amdgcn_cosf(xr); rope[pos * 32 + 16 + fi] = __builtin_amdgcn_sinf(xr);
        }
        if (bx == 0 && tid < 128) rope[4096 + tid] = (tid < 64) ? a_q_norm[tid] : a_k_norm[tid - 64];
    }
    grid.sync();
    const XcdBarrier xbar = xcd_barrier_post((unsigned*)(ws + WS_BAR), (volatile LAS unsigned*)(ldsp + LDS_MISC));
#define GRID_SYNC() xcd_barrier(xbar)
#ifdef PROBE_SYNCS
    for (int rep_ = 0; rep_ < 12; ++rep_) GRID_SYNC();
#endif

#ifdef PROBE_DUP_P1
    for (int rep_ = 0; rep_ < 2; ++rep_)
#endif
    {
        pg8::Gemm g{XB, WqkvA_t, M_, NQKV_A, DM_, true}; pg8::StaticOrder S; S.init(M_, NQKV_A, G, bx);
        pg8::EpiQKV<0> E{Qb, (long)((WS_KA - WS_Q) / 2), (long)((WS_VA - WS_Q) / 2), ss, rope};
        pg8::gemm_phase<pg8::EpiQKV<0>, pg8::StaticOrder, PG8_ALIGN, PG8_SP2>(ldsp, g, S, E);
        if ((G != 256) || (bx >= 128)) {
            int tid1_ = threadIdx.x; asm volatile("" : "+v"(tid1_)); const int lane = tid1_ & 63;
            const int gw = (G != 256) ? (bx * NWAVES + wave) : ((bx - 128) * NWAVES + wave), NGW = (G != 256) ? G * NWAVES : 128 * NWAVES;
            CONVERT(b_w_qkv, DM_, NQKV_B, norm_mix + DM_, WqkvB_t, true);
            CONVERT(b_w_o, DM_, DM_, (const float*)nullptr, WoB_t, true);
            CONVERT(mlp_w_in + (size_t)DM_ * FF_, DM_, FF_, norm_mlp + DM_, Win1_t, true);
            CONVERT(mlp_w_out + (size_t)DM_ * FF_, FF_, DM_, (const float*)nullptr, Wout1_t, true);
        }
    }
    GRID_SYNC();

    {
        const int xcd = bx & 7, loc = bx >> 3;
#ifdef PROBE_DUP_ATTN
        constexpr int NREP_ = 24;
#else
        constexpr int NREP_ = 12;
#endif
        if (G == 256) {
            for (int ii = 0; ii < NREP_; ++ii) { const int i = ii % 12; const int grp = xcd * 3 + (i >> 2); const int b = grp >> 2, kvh = grp & 3, h = kvh * 4 + (i & 3);
                attn_body::bf16* Od = (NREP_ == 24 && ii < 12) ? (attn_body::bf16*)(ws + 257 * MiB) : (attn_body::bf16*)Ob;
                attn_body::attn_unit<8, 4>(b, h, kvh, loc, (const attn_body::bf16*)Qb, (const attn_body::bf16*)KA, (const attn_body::bf16*)VA, Od, (char*)lds); }
        } else {
            for (int L = bx; L < NB_ * 16 * 32; L += G) { const int qb = L & 31, h = (L >> 5) & 15, b = L >> 9;
                attn_body::attn_unit<8, 4>(b, h, h >> 2, qb, (const attn_body::bf16*)Qb, (const attn_body::bf16*)KA, (const attn_body::bf16*)VA, (attn_body::bf16*)Ob, (char*)lds); }
        }
        asm volatile("s_waitcnt vmcnt(0) lgkmcnt(0)" ::: "memory"); __syncthreads();
    }
    GRID_SYNC();

    {
        pg8::Gemm g{Ob, WoA_t, M_, DM_, DM_, true}; pg8::StaticOrder S; S.init(M_, DM_, G, bx);
        pg8::EpiRes E{XB, ss + 1 * M_};
        pg8::gemm_phase<pg8::EpiRes, pg8::StaticOrder, PG8_ALIGN, PG8_SP2>(ldsp, g, S, E);
    }
    GRID_SYNC();

#ifdef PROBE_DUP_MLPIN
    for (int rep_ = 0; rep_ < 2; ++rep_)
#endif
#ifdef PROBE_NOSTORE_MLPIN
    {
        pg8::Gemm g{XB, Win_t, M_, FF_, DM_, true}; pg8::StaticOrder S; S.init(M_, FF_, G, bx);
        pg8::EpiRelu2T<false> E{U, ss + 1 * M_};
        pg8::gemm_phase<pg8::EpiRelu2T<false>, pg8::StaticOrder, PG8_ALIGN, PG8_SP2>(ldsp, g, S, E);
    }
#endif
#ifdef PROBE_PARTSTORE_MLPIN
    {
        pg8::Gemm g{XB, Win_t, M_, FF_, DM_, true}; pg8::StaticOrder S; S.init(M_, FF_, G, bx);
        if ((bx >> 3) % PROBE_PARTSTORE_MLPIN == 0) { pg8::EpiRelu2T<true> E{U, ss + 1 * M_}; pg8::gemm_phase<pg8::EpiRelu2T<true>, pg8::StaticOrder, PG8_ALIGN, PG8_SP2>(ldsp, g, S, E); }
        else { pg8::EpiRelu2T<false> E{U, ss + 1 * M_}; pg8::gemm_phase<pg8::EpiRelu2T<false>, pg8::StaticOrder, PG8_ALIGN, PG8_SP2>(ldsp, g, S, E); }
    }
#endif
    {
        pg8::Gemm g{XB, Win_t, M_, FF_, DM_, true}; pg8::StaticOrder S; S.init(M_, FF_, G, bx);
        pg8::EpiRelu2 E{U, ss + 1 * M_};
        pg8::gemm_phase<pg8::EpiRelu2, pg8::StaticOrder, PG8_ALIGN, PG8_SP2>(ldsp, g, S, E);
    }
    GRID_SYNC();

#ifdef PROBE_DUP_P5
    {
#ifndef PROBE_P5_AMOD
#define PROBE_P5_AMOD 0
#endif
        pg8::Gemm g{U, Wout_t, M_, DM_, FF_, true, PROBE_P5_AMOD, (size_t)pg8::U_HALF_IMGS * 16384}; pg8::StaticOrder S; S.init(M_, DM_, G, bx);
        pg8::EpiRes E{Ob, (float*)((unsigned char*)out + 120 * MiB)};
        pg8::gemm_phase<pg8::EpiRes, pg8::StaticOrder, PG8_ALIGN, PG8_SP2>(ldsp, g, S, E);
    }
#endif
    {
        pg8::Gemm g{U, Wout_t, M_, DM_, FF_, true, 0, (size_t)pg8::U_HALF_IMGS * 16384}; pg8::StaticOrder S; S.init(M_, DM_, G, bx);
        pg8::EpiRes E{XB, ss + 2 * M_};
        pg8::gemm_phase<pg8::EpiRes, pg8::StaticOrder, PG8_ALIGN, PG8_SP2, 2>(ldsp, g, S, E);
    }
    GRID_SYNC();

    {
        pg8::Gemm g{XB, WqkvB_t, M_, NQKV_B, DM_, true}; pg8::StaticOrder S; S.init(M_, NQKV_B, G, bx);
        pg8::EpiQKV<1> E{Qb, (long)((WS_KB - WS_Q) / 2), (long)((WS_VB - WS_Q) / 2), ss + 2 * M_, rope};
        pg8::gemm_phase<pg8::EpiQKV<1>, pg8::StaticOrder, PG8_ALIGN, PG8_SP2>(ldsp, g, S, E);
    }
    GRID_SYNC();

    {
        const int xcd = bx & 7, loc = bx >> 3;
#ifdef PROBE_DUP_NATTEN
        for (int i = 0; i < 12; ++i) { const int bh = xcd * 12 + i; const int b = bh >> 4, h = bh & 15;
            attn_body::natten_unit<16>(b, h, loc, (const attn_body::bf16*)Qb, (const attn_body::bf16*)KB, (const attn_body::bf16*)VB, (attn_body::bf16*)(ws + 401 * MiB), b_rel_bias + h * 465, (char*)lds); }
#endif
        if (G == 256) {
            for (int i = 0; i < 12; ++i) { const int bh = xcd * 12 + i; const int b = bh >> 4, h = bh & 15;
                attn_body::natten_unit<16>(b, h, loc, (const attn_body::bf16*)Qb, (const attn_body::bf16*)KB, (const attn_body::bf16*)VB, (attn_body::bf16*)Ob, b_rel_bias + h * 465, (char*)lds); }
        } else {
            for (int L = bx; L < NB_ * 16 * 32; L += G) { const int j = L & 31, h = (L >> 5) & 15, b = L >> 9;
                attn_body::natten_unit<16>(b, h, j, (const attn_body::bf16*)Qb, (const attn_body::bf16*)KB, (const attn_body::bf16*)VB, (attn_body::bf16*)Ob, b_rel_bias + h * 465, (char*)lds); }
        }
        asm volatile("s_waitcnt vmcnt(0) lgkmcnt(0)" ::: "memory"); __syncthreads();
    }
    GRID_SYNC();

    {
        pg8::Gemm g{Ob, WoB_t, M_, DM_, DM_, true}; pg8::StaticOrder S; S.init(M_, DM_, G, bx);
        pg8::EpiRes E{XB, ss + 3 * M_};
        pg8::gemm_phase<pg8::EpiRes, pg8::StaticOrder, PG8_ALIGN, PG8_SP2>(ldsp, g, S, E);
    }
    GRID_SYNC();

    {
        pg8::Gemm g{XB, Win1_t, M_, FF_, DM_, true}; pg8::StaticOrder S; S.init(M_, FF_, G, bx);
        pg8::EpiRelu2 E{U, ss + 3 * M_};
        pg8::gemm_phase<pg8::EpiRelu2, pg8::StaticOrder, PG8_ALIGN, PG8_SP2>(ldsp, g, S, E);
    }
    GRID_SYNC();

    {
        pg8::Gemm g{U, Wout1_t, M_, DM_, FF_, true, 0, (size_t)pg8::U_HALF_IMGS * 16384}; pg8::StaticOrder S; S.init(M_, DM_, G, bx);
        pg8::EpiRes E{XB, ss + 4 * M_};
        pg8::gemm_phase<pg8::EpiRes, pg8::StaticOrder, PG8_ALIGN, PG8_SP2, 2>(ldsp, g, S, E);
    }
    GRID_SYNC();

    {
        const float* ss4 = ss + 4 * M_;
        int tid11_ = threadIdx.x; asm volatile("" : "+v"(tid11_)); const int lane = tid11_ & 63;
        f32x4 gn[2][2];
#pragma unroll
        for (int j = 0; j < 2; ++j) { gn[j][0] = ((const f32x4*)norm_final)[2 * (lane + 64 * j)]; gn[j][1] = ((const f32x4*)norm_final)[2 * (lane + 64 * j) + 1]; }
        for (int m0 = gw; m0 < M_; m0 += 2 * NGW) {
            v4u w[2][2];
#pragma unroll
            for (int q = 0; q < 2; ++q) { const int m = m0 + q * NGW; w[q][0] = *(const v4u*)((const char*)XB + pg8::img_off(m, 8 * lane, DM_ / 64)); w[q][1] = *(const v4u*)((const char*)XB + pg8::img_off(m, 8 * (lane + 64), DM_ / 64)); }
#pragma unroll
            for (int q = 0; q < 2; ++q) { const int m = m0 + q * NGW; const float rs = __builtin_amdgcn_rsqf(ss4[m] * (1.f / 1024.f) + 1e-6f);
                f32x4* orow = (f32x4*)(out + (size_t)m * DM_);
#pragma unroll
                for (int j = 0; j < 2; ++j) { const v4u t = w[q][j];
                    const f32x4 a = {__uint_as_float(t.x << 16), __uint_as_float(t.x & 0xffff0000u), __uint_as_float(t.y << 16), __uint_as_float(t.y & 0xffff0000u)};
                    const f32x4 b = {__uint_as_float(t.z << 16), __uint_as_float(t.z & 0xffff0000u), __uint_as_float(t.w << 16), __uint_as_float(t.w & 0xffff0000u)};
                    orow[2 * (lane + 64 * j)] = a * rs * gn[j][0]; orow[2 * (lane + 64 * j) + 1] = b * rs * gn[j][1]; } }
        }
    }
}

extern "C" void kernel_launch(void* const* d_in, const int* in_sizes, int n_in, void* d_out, int out_size, void* d_ws, size_t ws_size, hipStream_t stream) {
    static int grid = 0;
    if (grid == 0) {
        if (n_in != 14 || out_size != M_ * DM_ || ws_size < WS_END) { fprintf(stderr, "kernel_launch: unexpected shapes: n_in %d out %d ws %zu (need >= %zu)\n", n_in, out_size, ws_size, (size_t)WS_END); }
        int dev = 0, cus = 0, per_cu = 0;
        (void)hipGetDevice(&dev); (void)hipDeviceGetAttribute(&cus, hipDeviceAttributeMultiprocessorCount, dev);
        (void)hipFuncSetAttribute((const void*)mk_fwd, hipFuncAttributeMaxDynamicSharedMemorySize, LDS_TOTAL);
        if (hipOccupancyMaxActiveBlocksPerMultiprocessor(&per_cu, (const void*)mk_fwd, NWAVES * 64, LDS_TOTAL) != hipSuccess || per_cu < 1) per_cu = 1;
        (void)hipGetLastError();
        grid = cus * 1;
        if (grid <= 0) grid = 256;
    }
    Args a{};
    for (int i = 0; i < 14; ++i) a.in[i] = (const float*)d_in[i];
    a.out = (float*)d_out; a.ws = (unsigned char*)d_ws;
    void* kargs[] = {&a};
    hipError_t e = hipLaunchCooperativeKernel((const void*)mk_fwd, dim3(grid), dim3(NWAVES * 64), kargs, LDS_TOTAL, stream);
    if (e != hipSuccess) fprintf(stderr, "cooperative launch failed: %s (grid %d)\n", hipGetErrorString(e), grid);
}
```

```cpp
#include <hip/hip_runtime.h>
#include <hip/hip_cooperative_groups.h>
#include <hip/hip_bf16.h>
#include <cstdio>
#include <cstdint>
#include <cmath>
namespace pg8 {
#define PG8_LAS __attribute__((address_space(3)))
typedef unsigned short bf16_t;
typedef short bf16x8 __attribute__((ext_vector_type(8)));
typedef float f32x4 __attribute__((ext_vector_type(4)));
typedef unsigned u32x4 __attribute__((ext_vector_type(4)));
constexpr int BM = 256, BK = 64, HALF = 128, HTB = HALF * BK * 2  , STAGE_BYTES = 8 * HTB, NXCD = 8, WGM = 8;

__host__ __device__ __forceinline__ int lds_byte(int r, int c) { const int st = (r >> 4) * 2 + (c >> 5), rr = r & 15, cc = c & 31, ob = rr * 64 + cc * 2; return st * 1024 + (ob ^ (((ob >> 9) & 1) << 5)); }
__host__ __device__ __forceinline__ void stage_rc(int b, int& R, int& C) { const int st = b / 1024, sb = b % 1024, swz = sb ^ (((sb >> 9) & 1) << 5); R = (st >> 1) * 16 + swz / 64; C = (st & 1) * 32 + (swz % 64) / 2; }
__host__ __device__ __forceinline__ int perm32(int rho) { const int n = rho >> 4, i = rho & 15; return 8 * (i >> 2) + 4 * n + (i & 3); }

__host__ __device__ __forceinline__ size_t img_off(int row, int col, int KT) { return ((size_t)(row >> 7) * KT + (col >> 6)) * 16384 + lds_byte(row & 127, col & 63); }
struct Unit { int pm, pn; };
struct Gemm { const bf16_t* A; const bf16_t* Bt; int M, N, K; bool a_img; int amod = 0; size_t a_hstep = 0; };

struct StaticOrder {
    int nM, nN, nwg, G, c, rev;
    __host__ __device__ void init(int M, int N, int G_, int c_, int rev_ = 0) { nM = M / BM; nN = N / BM; nwg = nM * nN; G = G_; c = c_; rev = rev_; }
    __host__ __device__ bool next(int i, Unit& u) const {
        const long L = (long)i * G + c; if (L >= nwg) return false;
        int wgid = (int)L; { const int q = nwg / NXCD, r = nwg % NXCD, xcd = wgid % NXCD, off = wgid / NXCD; wgid = (xcd < r ? xcd * (q + 1) : r * (q + 1) + (xcd - r) * q) + off; }
        const int nig = WGM * nN, gid = wgid / nig, fm = gid * WGM, gsz = (nM - fm) < WGM ? (nM - fm) : WGM;
        u.pm = fm + ((wgid % nig) % gsz); u.pn = (wgid % nig) / gsz; if (rev) u.pm = nM - 1 - u.pm; return true;
    }
    __device__ __forceinline__ void a_ready(const Unit&) const {}
    __device__ __forceinline__ void done(const Unit&) const {}
};

__device__ __forceinline__ unsigned cvt_pk_bf16(float lo, float hi) { unsigned r; asm volatile("v_cvt_pk_bf16_f32 %0, %1, %2" : "=v"(r) : "v"(lo), "v"(hi)); return r; }
typedef float f32x2 __attribute__((ext_vector_type(2)));
#define PG8_APM(pm) (g.amod ? (pm) % g.amod : (pm))
template <class Epi, class Sched, bool ALIGN_EPI = false, bool SP2 = false, int A_AUX = 0  >
__device__ __forceinline__ void gemm_phase(PG8_LAS unsigned char* lds, const Gemm g, const Sched& S, const Epi& E) {
    int tid_ = threadIdx.x; asm volatile("" : "+v"(tid_));
    const int tid = tid_, wid = __builtin_amdgcn_readfirstlane(tid >> 6), lane = tid & 63, wr = wid >> 2, wc = wid & 3, fr = lane & 15, fq = lane >> 4;
    const int K = g.K, nt = K / BK;
    unsigned voffA[2], voffB[2];
#pragma unroll
    for (int i = 0; i < 2; ++i) { int R, C; stage_rc(tid * 16 + i * 8192, R, C); const int Rb = Epi::PERM ? ((R & ~31) + perm32(R & 31)) : R;
        (void)Rb;
        voffA[i] = g.a_img ? (unsigned)(tid * 16 + i * 8192) : (unsigned)(R * K + C) * 2u; voffB[i] = (unsigned)(tid * 16 + i * 8192); }
    const size_t kstep = g.a_img ? (size_t)(2 * HTB / 2) : (size_t)(BK * 2);
    const size_t kstepB = (size_t)HTB;
    const size_t hstep = (size_t)HALF * K * 2;
    const size_t tstep = 2 * hstep;
    const size_t hstepA = g.a_hstep ? g.a_hstep : hstep, tstepA = 2 * hstepA;
    const unsigned ldsw = (unsigned)wid * 1024u;
    const int aoff = lds_byte(wr * 64 + fr, fq * 8), boff = lds_byte(wc * 32 + fr, fq * 8);
#define PG8_SA(b, h) (((b) * 2 + (h)) * HTB)
#define PG8_SB(b, h) ((4 + (b) * 2 + (h)) * HTB)
#define PG8_STAGEA(bufoff, gbase, voff) do { _Pragma("unroll") for (int _i = 0; _i < 2; ++_i) \
        __builtin_amdgcn_global_load_lds((const unsigned*)((const char*)(gbase) + (voff)[_i]), (PG8_LAS unsigned*)(lds + (bufoff) + ldsw + _i * 8192), 16, 0, A_AUX); } while (0)
#define PG8_STAGE(bufoff, gbase, voff) do { _Pragma("unroll") for (int _i = 0; _i < 2; ++_i) \
        __builtin_amdgcn_global_load_lds((const unsigned*)((const char*)(gbase) + (voff)[_i]), (PG8_LAS unsigned*)(lds + (bufoff) + ldsw + _i * 8192), 16, 0, 0); } while (0)
#define PG8_LDA(dst, b, h) do { _Pragma("unroll") for (int m = 0; m < 4; ++m) _Pragma("unroll") for (int k = 0; k < 2; ++k) dst[m][k] = *(const PG8_LAS bf16x8*)(lds + PG8_SA(b, h) + aoff + m * 2048 + k * 1024); } while (0)
#define PG8_LDB(dst, b, h) do { _Pragma("unroll") for (int n = 0; n < 2; ++n) _Pragma("unroll") for (int k = 0; k < 2; ++k) dst[n][k] = *(const PG8_LAS bf16x8*)(lds + PG8_SB(b, h) + boff + n * 2048 + k * 1024); } while (0)
#define PG8_MMA(ai, bj, At, Bt) do { __builtin_amdgcn_s_setprio(1); _Pragma("unroll") for (int m = 0; m < 4; ++m) _Pragma("unroll") for (int n = 0; n < 2; ++n) _Pragma("unroll") for (int k = 0; k < 2; ++k) \
        acc[ai][bj][m][n] = __builtin_amdgcn_mfma_f32_16x16x32_bf16(Bt[n][k], At[m][k], acc[ai][bj][m][n], 0, 0, 0); __builtin_amdgcn_s_setprio(0); } while (0)
#define PG8_WAIT_V(n) asm volatile("s_waitcnt vmcnt(" #n ")" ::: "memory")
#define PG8_WAIT_L(n) asm volatile("s_waitcnt lgkmcnt(" #n ")" ::: "memory")
#define PG8_BAR __builtin_amdgcn_s_barrier()
#define PG8_SCHED __builtin_amdgcn_sched_barrier(0)
    Unit cur, nxt; int ui = 0;
    if (!S.next(0, cur)) return;
    f32x4 acc[2][2][4][2]; typename Epi::Carry carry;
    E.init(acc, carry, cur, wr, wc, fr, fq);
    bf16x8 At[4][2], B0[2][2], B1[2][2];
    const char* cA = (const char*)g.A + (size_t)PG8_APM(cur.pm) * tstepA; const char* cB = (const char*)g.Bt + (size_t)cur.pn * tstep;
    S.a_ready(cur);
    if constexpr (SP2) {
        PG8_STAGE(PG8_SB(0, 0), cB, voffB); PG8_STAGE(PG8_SB(0, 1), cB + hstep, voffB); PG8_STAGEA(PG8_SA(0, 0), cA, voffA); PG8_STAGEA(PG8_SA(0, 1), cA + hstepA, voffA);
        if (wr == 1) PG8_BAR;
        PG8_WAIT_V(2); PG8_BAR;
        PG8_STAGE(PG8_SB(1, 0), cB + kstepB, voffB); PG8_STAGEA(PG8_SA(1, 0), cA + kstep, voffA); PG8_STAGE(PG8_SB(1, 1), cB + hstep + kstepB, voffB);
        PG8_WAIT_V(6); PG8_BAR;
    } else {
        PG8_STAGE(PG8_SB(0, 0), cB, voffB); PG8_STAGEA(PG8_SA(0, 0), cA, voffA); PG8_STAGE(PG8_SB(0, 1), cB + hstep, voffB); PG8_STAGEA(PG8_SA(0, 1), cA + hstepA, voffA);
        if (wr == 1) PG8_BAR;
        PG8_WAIT_V(4); PG8_BAR;
        PG8_STAGE(PG8_SB(1, 0), cB + kstepB, voffB); PG8_STAGEA(PG8_SA(1, 0), cA + kstep, voffA); PG8_STAGE(PG8_SB(1, 1), cB + hstep + kstepB, voffB);
        PG8_WAIT_V(6); PG8_BAR;
    }
    for (;;) {
        const bool has_next = S.next(ui + 1, nxt);
        const char* nA = has_next ? (const char*)g.A + (size_t)PG8_APM(nxt.pm) * tstepA : cA; const char* nB = has_next ? (const char*)g.Bt + (size_t)nxt.pn * tstep : cB;
        for (int t = 0; t < nt; t += 2) {
            const bool last = (t == nt - 2);
            const char* a1 = cA + (size_t)(t + 1) * kstep;
            const char* a2 = last ? nA : cA + (size_t)(t + 2) * kstep; const char* b2 = last ? nB : cB + (size_t)(t + 2) * kstepB;
            const char* a3 = a2 + kstep; const char* b3 = b2 + kstepB;
            if (last && has_next) S.a_ready(nxt);
            if constexpr (SP2) {
            PG8_LDB(B0, 0, 0); PG8_LDB(B1, 0, 1); PG8_SCHED; PG8_LDA(At, 0, 0); PG8_STAGEA(PG8_SA(1, 1), a1 + hstepA, voffA);
            PG8_WAIT_V(8); PG8_WAIT_L(0); PG8_BAR; PG8_MMA(0, 0, At, B0); PG8_MMA(0, 1, At, B1); PG8_BAR; PG8_SCHED;
            PG8_LDA(At, 0, 1); PG8_STAGE(PG8_SB(0, 0), b2, voffB); PG8_STAGE(PG8_SB(0, 1), b2 + hstep, voffB); PG8_STAGEA(PG8_SA(0, 0), a2, voffA);
            PG8_WAIT_V(8); PG8_WAIT_L(0); PG8_BAR; PG8_MMA(1, 0, At, B0); PG8_MMA(1, 1, At, B1); PG8_BAR; PG8_SCHED;
            PG8_LDB(B0, 1, 0); PG8_LDB(B1, 1, 1); PG8_SCHED; PG8_LDA(At, 1, 0); PG8_STAGEA(PG8_SA(0, 1), a2 + hstepA, voffA);
            PG8_WAIT_V(8); PG8_WAIT_L(0); PG8_BAR; PG8_MMA(0, 0, At, B0); PG8_MMA(0, 1, At, B1); PG8_BAR; PG8_SCHED;
            PG8_LDA(At, 1, 1); PG8_STAGE(PG8_SB(1, 0), b3, voffB); PG8_STAGE(PG8_SB(1, 1), b3 + hstep, voffB); PG8_STAGEA(PG8_SA(1, 0), a3, voffA);
            PG8_WAIT_V(8); PG8_WAIT_L(0); PG8_BAR; PG8_MMA(1, 0, At, B0); PG8_MMA(1, 1, At, B1); PG8_BAR; PG8_SCHED;
            } else {
            PG8_LDB(B0, 0, 0); PG8_SCHED; PG8_LDA(At, 0, 0); PG8_STAGEA(PG8_SA(1, 1), a1 + hstepA, voffA);
            PG8_WAIT_L(8); PG8_BAR; PG8_WAIT_L(0); PG8_MMA(0, 0, At, B0); PG8_BAR; PG8_SCHED;
            PG8_LDB(B1, 0, 1); PG8_STAGE(PG8_SB(0, 0), b2, voffB);
            PG8_BAR; PG8_WAIT_L(0); PG8_MMA(0, 1, At, B1); PG8_BAR;
            PG8_LDA(At, 0, 1); PG8_STAGEA(PG8_SA(0, 0), a2, voffA);
            PG8_BAR; PG8_WAIT_L(0); PG8_MMA(1, 0, At, B0); PG8_BAR; PG8_SCHED;
            PG8_STAGE(PG8_SB(0, 1), b2 + hstep, voffB);
            PG8_WAIT_V(6); PG8_BAR; PG8_MMA(1, 1, At, B1); PG8_BAR;
            PG8_LDB(B0, 1, 0); PG8_SCHED; PG8_LDA(At, 1, 0); PG8_STAGEA(PG8_SA(0, 1), a2 + hstepA, voffA);
            PG8_WAIT_L(8); PG8_BAR; PG8_WAIT_L(0); PG8_MMA(0, 0, At, B0); PG8_BAR; PG8_SCHED;
            PG8_LDB(B1, 1, 1); PG8_STAGE(PG8_SB(1, 0), b3, voffB);
            PG8_BAR; PG8_WAIT_L(0); PG8_MMA(0, 1, At, B1); PG8_BAR;
            PG8_LDA(At, 1, 1); PG8_STAGEA(PG8_SA(1, 0), a3, voffA);
            PG8_BAR; PG8_WAIT_L(0); PG8_MMA(1, 0, At, B0); PG8_BAR; PG8_SCHED;
            PG8_STAGE(PG8_SB(1, 1), b3 + hstep, voffB);
            PG8_WAIT_V(6); PG8_BAR; PG8_MMA(1, 1, At, B1); PG8_BAR;
            }
        }
        if constexpr (ALIGN_EPI) { if (wr == 0) PG8_BAR; }
        if constexpr (!Epi::AFTER_DRAIN) { E(acc, carry, cur, wr, wc, fr, fq); S.done(cur); }
        if (!has_next) break;
        E.init(acc, carry, nxt, wr, wc, fr, fq);
        cur = nxt; cA = nA; cB = nB; ++ui;
        if constexpr (ALIGN_EPI) { if (wr == 1) PG8_BAR; }
    }
    PG8_WAIT_V(0);
    if constexpr (!ALIGN_EPI) { if (wr == 0) PG8_BAR; }
    PG8_BAR;

#undef PG8_SA
#undef PG8_SB
#undef PG8_STAGE
#undef PG8_STAGEA
#undef PG8_LDA
#undef PG8_LDB
#undef PG8_MMA
#undef PG8_WAIT_V
#undef PG8_WAIT_L
#undef PG8_BAR
#undef PG8_SCHED
}
}

#ifndef PG8_SP2
#define PG8_SP2 true
#endif
#ifndef PG8_ALIGN
#define PG8_ALIGN true
#endif
namespace attn_body {
using bf16=__hip_bfloat16;
using bf16x8=__attribute__((ext_vector_type(8)))short;
using s16x4=__attribute__((ext_vector_type(4)))short;
using f32x16=__attribute__((ext_vector_type(16)))float;
using u32x4=__attribute__((ext_vector_type(4)))unsigned;
constexpr int BATCH=6,NHEAD=16,SEQ=8192,D=64,DM=NHEAD*D;
constexpr int NW=8,QBLK=32,QB=QBLK*NW,KVBLK=64,NQB=SEQ/QB;
constexpr int ATTN_PITCH=DM, ATTN_UNIT_ROWS=QB;
constexpr int NT_IMG=SEQ/KVBLK;
__device__ __forceinline__ int crow(int r,int hi){return (r&3)+8*(r>>2)+4*hi;}
#define SBAR() __builtin_amdgcn_sched_barrier(0)
__device__ __forceinline__ void cmask(f32x16&p0,f32x16&p1,int jb,int qrel,int hi){
  const float NEG=-INFINITY; int kb=64*jb+4*hi;
  #pragma unroll
  for(int r=0;r<16;++r){int kv=kb+(r&3)+8*(r>>2); if(kv>qrel)p0[r]=NEG; if(kv+32>qrel)p1[r]=NEG;}
}

constexpr int NSLOT=3, SLOTB=8192;
constexpr int LDS_K=0, LDS_V=NSLOT*SLOTB, LDS_WS=2*NSLOT*SLOTB, LDS_OST=LDS_WS+NW*64*4, LDS_BYTES=LDS_OST+NW*4096;
constexpr float C2=0.125f*1.4426950408889634f;
__device__ __forceinline__ void glds16(const void*gsrc,unsigned lds_dst){unsigned keep;
  asm volatile("s_mov_b32 %0, m0\n\ts_mov_b32 m0, %2\n\ts_nop 0\n\tglobal_load_lds_dwordx4 %1, off\n\ts_mov_b32 m0, %0":"=&s"(keep):"v"(gsrc),"s"(lds_dst):"memory");}
__device__ __forceinline__ float max3f(float a,float b,float c){float r;asm("v_max3_f32 %0, %1, %2, %3":"=v"(r):"v"(a),"v"(b),"v"(c));return r;}
__device__ __forceinline__ float max2f(float a,float b){float r;asm("v_max_f32_e32 %0, %1, %2":"=v"(r):"v"(a),"v"(b));return r;}
__device__ __forceinline__ float fadd_s(float a,float b){float r;asm("v_add_f32_e32 %0, %1, %2":"=v"(r):"v"(a),"v"(b));return r;}
__device__ __forceinline__ float fsub_s(float a,float b){float r;asm("v_sub_f32_e32 %0, %1, %2":"=v"(r):"v"(a),"v"(b));return r;}
typedef float f32x2_t __attribute__((ext_vector_type(2))); typedef __bf16 bf16x2_t __attribute__((ext_vector_type(2)));
__device__ __forceinline__ unsigned cvtpk_s(float lo,float hi){f32x2_t v={lo,hi};bf16x2_t b=__builtin_convertvector(v,bf16x2_t);return __builtin_bit_cast(unsigned,b);}
#define WAIT_BAR(N) asm volatile("s_waitcnt vmcnt(" #N ") lgkmcnt(0)\n\ts_barrier":::"memory")

__device__ __forceinline__ void qkt(f32x16&p0,f32x16&p1,const char*Kslot,const bf16x8*qr,const f32x16&negm,int r32,int hi){
  const char*kb=Kslot+hi*1024+r32*16;
  #pragma unroll
  for(int d0=0;d0<4;++d0){
    const bf16x8 b0=*reinterpret_cast<const bf16x8*>(kb+d0*2048);
    const bf16x8 b1=*reinterpret_cast<const bf16x8*>(kb+d0*2048+512);
    if(d0==0){p0=__builtin_amdgcn_mfma_f32_32x32x16_bf16(b0,qr[0],negm,0,0,0);p1=__builtin_amdgcn_mfma_f32_32x32x16_bf16(b1,qr[0],negm,0,0,0);}
    else{p0=__builtin_amdgcn_mfma_f32_32x32x16_bf16(b0,qr[d0],p0,0,0,0);p1=__builtin_amdgcn_mfma_f32_32x32x16_bf16(b1,qr[d0],p1,0,0,0);}}
}
typedef __attribute__((address_space(3))) const char* lds_cptr;
typedef short v4i16_t __attribute__((ext_vector_type(4)));
__device__ __forceinline__ void kload8(bf16x8*kf,lds_cptr kp){
  kf[0]=*(const __attribute__((address_space(3))) bf16x8*)(kp);      kf[1]=*(const __attribute__((address_space(3))) bf16x8*)(kp+512);
  kf[2]=*(const __attribute__((address_space(3))) bf16x8*)(kp+2048); kf[3]=*(const __attribute__((address_space(3))) bf16x8*)(kp+2560);
  kf[4]=*(const __attribute__((address_space(3))) bf16x8*)(kp+4096); kf[5]=*(const __attribute__((address_space(3))) bf16x8*)(kp+4608);
  kf[6]=*(const __attribute__((address_space(3))) bf16x8*)(kp+6144); kf[7]=*(const __attribute__((address_space(3))) bf16x8*)(kp+6656);
}
__device__ __forceinline__ void kload2(bf16x8*kf,lds_cptr kp,int j){ kf[2*j]=*(const __attribute__((address_space(3))) bf16x8*)(kp+j*2048); kf[2*j+1]=*(const __attribute__((address_space(3))) bf16x8*)(kp+j*2048+512); }
__device__ __forceinline__ s16x4 vtr(lds_cptr p){ return __builtin_bit_cast(s16x4,__builtin_amdgcn_ds_read_tr16_b64_v4i16((__attribute__((address_space(3))) v4i16_t*)p)); }
__device__ __forceinline__ float rowmax(const f32x16&p0,const f32x16&p1){
  float a=max3f(p0[0],p0[1],p1[0]),b=max3f(p0[2],p0[3],p1[1]);a=max3f(a,p1[2],p1[3]);
  #pragma unroll
  for(int r=4;r<16;r+=4){a=max3f(a,p0[r],p0[r+1]);b=max3f(b,p0[r+2],p0[r+3]);a=max3f(a,p1[r],p1[r+1]);b=max3f(b,p1[r+2],p1[r+3]);}
  const float m=max2f(a,b);
  auto rr=__builtin_amdgcn_permlane32_swap(__float_as_uint(m),__float_as_uint(m),false,false);
  return max2f(__uint_as_float(rr[0]),__uint_as_float(rr[1]));
}
__device__ __forceinline__ void pv(f32x16*o,int vb,bf16x8 pa0,bf16x8 pa1,bf16x8 pa2,bf16x8 pa3){
  #pragma unroll
  for(int d0=0;d0<2;++d0){s16x4 lo[4],hi[4];
    #pragma unroll
    for(int ks=0;ks<4;++ks){
      asm volatile("ds_read_b64_tr_b16 %0,%1 offset:%c2":"=&v"(lo[ks]):"v"(vb),"i"(d0*4096+ks*1024):"memory");
      asm volatile("ds_read_b64_tr_b16 %0,%1 offset:%c2":"=&v"(hi[ks]):"v"(vb),"i"(d0*4096+ks*1024+512):"memory");}
    asm volatile("s_waitcnt lgkmcnt(0)":::"memory");SBAR();
    #define PK(k) (bf16x8){lo[k][0],lo[k][1],lo[k][2],lo[k][3],hi[k][0],hi[k][1],hi[k][2],hi[k][3]}
    o[d0]=__builtin_amdgcn_mfma_f32_32x32x16_bf16(pa0,PK(0),o[d0],0,0,0);
    o[d0]=__builtin_amdgcn_mfma_f32_32x32x16_bf16(pa1,PK(1),o[d0],0,0,0);
    o[d0]=__builtin_amdgcn_mfma_f32_32x32x16_bf16(pa2,PK(2),o[d0],0,0,0);
    o[d0]=__builtin_amdgcn_mfma_f32_32x32x16_bf16(pa3,PK(3),o[d0],0,0,0);
    #undef PK
  }
}

#ifndef ATTN_STORE16
#define ATTN_STORE16(p,v) __builtin_nontemporal_store((v),(u32x4*)(p))
#define ATTN_STORE16_PLAIN(p,v) (*(u32x4*)(p)=(v))
#endif
template<int THRL,int KP> __device__ __forceinline__ void attn_unit(int b,int h,int kvh,int qb,const bf16*Q,const bf16*__restrict__ K,const bf16*__restrict__ V,bf16*O,char*shm){
  int tid_=threadIdx.x; asm volatile("":"+v"(tid_));
  const int tid=tid_,lane=tid&63,r32=lane&31,hi=lane>>5; const int wid=__builtin_amdgcn_readfirstlane(tid>>6);
  const long rowbase=(long)b*SEQ; const int q0=qb*QB;
  const bf16*Qw=Q+(rowbase+q0+wid*QBLK)*DM+h*D;
  const bf16*Kh=K+((long)b*KP+kvh)*(long)(NT_IMG*4096),*Vh=V+((long)b*KP+kvh)*(long)(NT_IMG*4096);
  const unsigned lds0=(unsigned)(uintptr_t)shm;
  float*wsf=(float*)(shm+LDS_WS)+wid*64;
  const bf16*ksrc=Kh+wid*512+lane*8;
  const bf16*vsrc=Vh+wid*512+lane*8;
  const unsigned kdst=lds0+LDS_K+wid*1024, vdst=lds0+LDS_V+wid*1024;
  #define DMA_K(t,slot) glds16(ksrc+(long)(t)*4096,(unsigned)__builtin_amdgcn_readfirstlane(kdst+(slot)))
  #define DMA_V(t,slot) glds16(vsrc+(long)(t)*4096,(unsigned)__builtin_amdgcn_readfirstlane(vdst+(slot)))
  const int vb0=(int)(lds0+LDS_V)+((lane>>4)&1)*32+(lane&3)*8+(4*hi+((lane&15)>>2))*64;
  const char*Kbase=shm+LDS_K; bf16x8 kf[8];
  const lds_cptr shm3=(lds_cptr)shm; const lds_cptr kp0=shm3+LDS_K+hi*1024+r32*16; const lds_cptr vp0=shm3+LDS_V+((lane>>4)&1)*32+(lane&3)*8+(4*hi+((lane&15)>>2))*64;
  const int NT=SEQ/KVBLK;
  DMA_K(0,0);DMA_V(0,0);DMA_K(1,SLOTB);
  bf16x8 qr[4];
  #pragma unroll
  for(int d0=0;d0<4;++d0)qr[d0]=*reinterpret_cast<const bf16x8*>(&Qw[(long)r32*DM+d0*16+hi*8]);
  asm volatile("s_waitcnt vmcnt(0)":"+v"(qr[0]),"+v"(qr[1]),"+v"(qr[2]),"+v"(qr[3])::"memory");
  float mhat=0.f,l_reg=0.f;f32x16 o[2];o[0]=f32x16{};o[1]=f32x16{};f32x16 negm=f32x16{};asm volatile("":"+v"(negm));
    #define CMASK(P0,P1,t) do{}while(0)
  bool resc=false;
  #define START(P0,P1) do{ const float rm=rowmax(P0,P1); resc=false; \
    { const float dl=rm; mhat=fadd_s(mhat,dl); \
      _Pragma("unroll") for(int r=0;r<16;++r){P0[r]=fsub_s(P0[r],dl);P1[r]=fsub_s(P1[r],dl);} \
      _Pragma("unroll") for(int r=0;r<16;++r)negm[r]=-mhat; asm volatile("":"+v"(negm)); } \
    _Pragma("unroll") for(int r=0;r<16;++r)P0[r]=__builtin_amdgcn_exp2f(P0[r]); }while(0)
  #define RESC() do{ if(resc){ asm volatile("s_waitcnt lgkmcnt(0)":::"memory"); \
      _Pragma("unroll") for(int d_=0;d_<2;++d_) _Pragma("unroll") for(int r=0;r<16;++r)o[d_][r]*=wsf[crow(r,hi)]; } }while(0)
  f32x16 pA0,pA1,pB0,pB1;
  int sl_prev=0,sl_cur=0,sl_next=SLOTB;
  #define ROT() do{sl_prev=sl_cur;sl_cur=sl_next;sl_next=(sl_next==(NSLOT-1)*SLOTB)?0:sl_next+SLOTB;}while(0)
  DMA_K(2,2*SLOTB);
  WAIT_BAR(3);
  qkt(pA0,pA1,Kbase,qr,negm,r32,hi);asm volatile("s_nop 15\n\ts_nop 7":"+v"(pA0),"+v"(pA1));CMASK(pA0,pA1,0);
  START(pA0,pA1);
  _Pragma("unroll") for(int r=0;r<16;++r)pA1[r]=__builtin_amdgcn_exp2f(pA1[r]);
  WAIT_BAR(0);
  DMA_K(3,0);DMA_V(1,SLOTB);
  ROT();
  kload8(kf,kp0+sl_cur);
  WAIT_BAR(2);
  s16x4 vlo[8],vhi[8]; u32x4 pw0,pw1,pw2,pw3;
  #define PKW(P,B) cvtpk_s(P[B],P[B+1])
  #define PAF(k) __builtin_bit_cast(bf16x8,pw##k)
  #define VFR(i) (bf16x8){vlo[i][0],vlo[i][1],vlo[i][2],vlo[i][3],vhi[i][0],vhi[i][1],vhi[i][2],vhi[i][3]}
  #define PIN(x) asm volatile("":"+v"(x))
  #define MX3(a,b,c) __builtin_fmaxf(__builtin_fmaxf((a),(b)),(c))
  #define GAPA(MF,A0,A1,A2,A3,W0,W1,PW) do{ MF; sacc+=A0; sacc+=A1; sacc+=A2; sacc+=A3; PIN(sacc); W0; W1; PIN(PW); SBAR(); }while(0)
  #define EX(v) __builtin_amdgcn_exp2f(v)
  #define GAPB(MF,X,B) do{ MF; X[B]=EX(X[B]); X[B+1]=EX(X[B+1]); X[B+2]=EX(X[B+2]); X[B+3]=EX(X[B+3]); PIN(X); SBAR(); }while(0)
  #define VRD(i) do{ vlo[i]=vtr(vp_+(((i)>>2)*4096+((i)&3)*1024)); vhi[i]=vtr(vp_+(((i)>>2)*4096+((i)&3)*1024+512)); }while(0)
  #define KRD(G,j) do{ if(G){ kload2(kf,kp0+sl_next,j); SBAR(); } }while(0)
  #define STEP(C0,C1,P0,P1,t,GK,GV,GL) do{ SBAR(); \
    const lds_cptr vp_=vp0+sl_prev; \
    VRD(0); SBAR(); float sacc=(P0[0]+P0[1]); \
    GAPA(C0=__builtin_amdgcn_mfma_f32_32x32x16_bf16(kf[0],qr[0],negm,0,0,0), P0[2],P0[3],P0[4],P0[5],     pw0[0]=PKW(P0,0), pw0[1]=PKW(P0,2), pw0); \
    VRD(4); SBAR(); GAPA(C1=__builtin_amdgcn_mfma_f32_32x32x16_bf16(kf[1],qr[0],negm,0,0,0), P0[6],P0[7],P0[8],P0[9],     pw0[2]=PKW(P0,4), pw0[3]=PKW(P0,6), pw0); \
    VRD(1); SBAR(); GAPA(C0=__builtin_amdgcn_mfma_f32_32x32x16_bf16(kf[2],qr[1],C0,0,0,0),   P0[10],P0[11],P0[12],P0[13], pw1[0]=PKW(P0,8), pw1[1]=PKW(P0,10), pw1); \
    VRD(5); SBAR(); GAPA(C1=__builtin_amdgcn_mfma_f32_32x32x16_bf16(kf[3],qr[1],C1,0,0,0),   P0[14],P0[15],P1[0],P1[1],   pw1[2]=PKW(P0,12),pw1[3]=PKW(P0,14), pw1); \
    VRD(2); SBAR(); GAPA(C0=__builtin_amdgcn_mfma_f32_32x32x16_bf16(kf[4],qr[2],C0,0,0,0),   P1[2],P1[3],P1[4],P1[5],     pw2[0]=PKW(P1,0), pw2[1]=PKW(P1,2), pw2); \
    VRD(6); SBAR(); GAPA(C1=__builtin_amdgcn_mfma_f32_32x32x16_bf16(kf[5],qr[2],C1,0,0,0),   P1[6],P1[7],P1[8],P1[9],     pw2[2]=PKW(P1,4), pw2[3]=PKW(P1,6), pw2); \
    VRD(3); SBAR(); GAPA(C0=__builtin_amdgcn_mfma_f32_32x32x16_bf16(kf[6],qr[3],C0,0,0,0),   P1[10],P1[11],P1[12],P1[13], pw3[0]=PKW(P1,8), pw3[1]=PKW(P1,10), pw3); \
    VRD(7); SBAR(); GAPA(C1=__builtin_amdgcn_mfma_f32_32x32x16_bf16(kf[7],qr[3],C1,0,0,0),   P1[14],P1[15],0.f,0.f,       pw3[2]=PKW(P1,12),pw3[3]=PKW(P1,14), pw3); \
    l_reg+=sacc; \
    if(GK){DMA_K((t)+3,sl_cur);} if(GV){DMA_V((t)+1,sl_next);} \
    CMASK(C0,C1,t); \
    { float a=MX3(C0[0],C0[1],C1[0]),b=MX3(C0[2],C0[3],C1[1]); a=MX3(a,C1[2],C1[3]); \
      _Pragma("unroll") for(int r=4;r<16;r+=4){a=MX3(a,C0[r],C0[r+1]);b=MX3(b,C0[r+2],C0[r+3]);a=MX3(a,C1[r],C1[r+1]);b=MX3(b,C1[r+2],C1[r+3]);} \
      float rm=__builtin_fmaxf(a,b); { auto rr=__builtin_amdgcn_permlane32_swap(__float_as_uint(rm),__float_as_uint(rm),false,false); rm=__builtin_fmaxf(__uint_as_float(rr[0]),__uint_as_float(rr[1])); } \
      resc=false; \
      if(__builtin_expect(__any(rm>(float)THRL),0)){ const float dl=__builtin_fmaxf(rm,0.f); mhat+=dl; \
        _Pragma("unroll") for(int r=0;r<16;++r){C0[r]-=dl;C1[r]-=dl;} \
        _Pragma("unroll") for(int r=0;r<16;++r)negm[r]=-mhat; asm volatile("":"+v"(negm)); \
        const float f=__builtin_amdgcn_exp2f(-dl); l_reg*=f; if(hi==0)wsf[r32]=f; resc=true; } } \
    SBAR(); \
    GAPB(o[0]=__builtin_amdgcn_mfma_f32_32x32x16_bf16(PAF(0),VFR(0),o[0],0,0,0), C0,0); \
    GAPB(o[1]=__builtin_amdgcn_mfma_f32_32x32x16_bf16(PAF(0),VFR(4),o[1],0,0,0), C0,4); \
    KRD(GL,0); GAPB(o[0]=__builtin_amdgcn_mfma_f32_32x32x16_bf16(PAF(1),VFR(1),o[0],0,0,0), C0,8); \
    KRD(GL,1); GAPB(o[1]=__builtin_amdgcn_mfma_f32_32x32x16_bf16(PAF(1),VFR(5),o[1],0,0,0), C0,12); \
    KRD(GL,2); GAPB(o[0]=__builtin_amdgcn_mfma_f32_32x32x16_bf16(PAF(2),VFR(2),o[0],0,0,0), C1,0); \
    KRD(GL,3); GAPB(o[1]=__builtin_amdgcn_mfma_f32_32x32x16_bf16(PAF(2),VFR(6),o[1],0,0,0), C1,4); \
    GAPB(o[0]=__builtin_amdgcn_mfma_f32_32x32x16_bf16(PAF(3),VFR(3),o[0],0,0,0), C1,8); \
    GAPB(o[1]=__builtin_amdgcn_mfma_f32_32x32x16_bf16(PAF(3),VFR(7),o[1],0,0,0), C1,12); \
    }while(0)
  int t=1;
  #undef CMASK
  #define CMASK(P0,P1,t) do{}while(0)
  for(;t+5<NT;t+=2){
    STEP(pB0,pB1,pA0,pA1,t,true,true,true);     WAIT_BAR(2); RESC(); ROT();
    STEP(pA0,pA1,pB0,pB1,t+1,true,true,true);   WAIT_BAR(2); RESC(); ROT();
  }
  #undef CMASK
  #define CMASK(P0,P1,t) do{}while(0)
  #define ENDW(tt) do{ if((tt)+3<NT){WAIT_BAR(2);} else if((tt)+2<NT){WAIT_BAR(1);} else {WAIT_BAR(0);} }while(0)
  for(;t+1<NT;t+=2){
    STEP(pB0,pB1,pA0,pA1,t,(t+3<NT),(t+1<NT),(t+1<NT));       ENDW(t);   RESC(); ROT();
    STEP(pA0,pA1,pB0,pB1,t+1,(t+4<NT),(t+2<NT),(t+2<NT));     ENDW(t+1); RESC(); ROT();
  }
  STEP(pB0,pB1,pA0,pA1,NT-1,false,false,false); RESC();
  { float sacc=pB0[0]+pB0[1]; _Pragma("unroll") for(int r=2;r<16;++r)sacc+=pB0[r]; _Pragma("unroll") for(int r=0;r<16;++r)sacc+=pB1[r]; l_reg+=sacc;
    pw0=(u32x4){PKW(pB0,0),PKW(pB0,2),PKW(pB0,4),PKW(pB0,6)};pw1=(u32x4){PKW(pB0,8),PKW(pB0,10),PKW(pB0,12),PKW(pB0,14)};pw2=(u32x4){PKW(pB1,0),PKW(pB1,2),PKW(pB1,4),PKW(pB1,6)};pw3=(u32x4){PKW(pB1,8),PKW(pB1,10),PKW(pB1,12),PKW(pB1,14)};
    SBAR(); pv(o,vb0+sl_cur,PAF(0),PAF(1),PAF(2),PAF(3)); }
  #undef PKW
  #undef PAF
  #undef VFR
  #undef PIN
  #undef MX3
  #undef GAPA
  #undef GAPB
  #undef EX
  #undef VRD
  #undef KRD
  #undef STEP
  #undef ENDW
  {auto rr=__builtin_amdgcn_permlane32_swap(__float_as_uint(l_reg),__float_as_uint(l_reg),false,false);l_reg=__uint_as_float(rr[0])+__uint_as_float(rr[1]);}
  if(hi==0)wsf[32+r32]=l_reg;asm volatile("s_waitcnt lgkmcnt(0)":::"memory");
  float rli[16];
  #pragma unroll
  for(int r=0;r<16;++r)rli[r]=__builtin_amdgcn_rcpf(wsf[32+crow(r,hi)]);
    { bf16*stg=(bf16*)(shm+LDS_OST)+wid*2048;
    #pragma unroll
    for(int r=0;r<16;++r){const int orow=crow(r,hi);
      #pragma unroll
      for(int d0=0;d0<2;++d0)stg[orow*64+d0*32+r32]=__float2bfloat16(o[d0][r]*rli[r]);}
    asm volatile("s_waitcnt lgkmcnt(0)":::"memory");
    #pragma unroll
    for(int i=0;i<4;++i){const int row=i*8+(lane>>3),ch=lane&7; const u32x4 v=*(const u32x4*)(stg+row*64+ch*8);
      ATTN_STORE16((char*)O+pg8::img_off((int)(rowbase+q0+wid*QBLK)+row,h*D+ch*8,DM/64),v);} }
  asm volatile("s_waitcnt lgkmcnt(0)\n\ts_barrier":::"memory");
  #undef DMA_K
  #undef DMA_V
  #undef CMASK
  #undef START
  #undef RESC
  #undef ROT
}
constexpr int ATTN_LDS_BYTES=LDS_BYTES;
constexpr int N_NSLOT=4, N_LDS_K=0, N_LDS_V=N_NSLOT*SLOTB, N_LDS_WS=2*N_NSLOT*SLOTB, N_LDS_OST=N_LDS_WS+NW*64*4, NAT_BIAS_OFF=N_LDS_OST+NW*4096;
__device__ __forceinline__ void qkt32(f32x16&p0,const char*Kw,const bf16x8*qr,const f32x16&c0,int r32,int hi){
  const char*kb=Kw+hi*1024+r32*16;
  #pragma unroll
  for(int d0=0;d0<4;++d0){ const bf16x8 b0=*reinterpret_cast<const bf16x8*>(kb+d0*2048);
    if(d0==0)p0=__builtin_amdgcn_mfma_f32_32x32x16_bf16(b0,qr[0],c0,0,0,0); else p0=__builtin_amdgcn_mfma_f32_32x32x16_bf16(b0,qr[d0],p0,0,0,0);}
}
__device__ __forceinline__ void pv32(f32x16*o,int vb,bf16x8 pa0,bf16x8 pa1){
  #pragma unroll
  for(int d0=0;d0<2;++d0){s16x4 lo[2],hi[2];
    #pragma unroll
    for(int ks=0;ks<2;++ks){
      asm volatile("ds_read_b64_tr_b16 %0,%1 offset:%c2":"=&v"(lo[ks]):"v"(vb),"i"(d0*4096+ks*1024):"memory");
      asm volatile("ds_read_b64_tr_b16 %0,%1 offset:%c2":"=&v"(hi[ks]):"v"(vb),"i"(d0*4096+ks*1024+512):"memory");}
    asm volatile("s_waitcnt lgkmcnt(0)":::"memory");SBAR();
    #define PK(k) (bf16x8){lo[k][0],lo[k][1],lo[k][2],lo[k][3],hi[k][0],hi[k][1],hi[k][2],hi[k][3]}
    o[d0]=__builtin_amdgcn_mfma_f32_32x32x16_bf16(pa0,PK(0),o[d0],0,0,0);
    o[d0]=__builtin_amdgcn_mfma_f32_32x32x16_bf16(pa1,PK(1),o[d0],0,0,0);
    #undef PK
  }
}
template<int KP> __device__ __forceinline__ void natten_unit(int b,int h,int j,const bf16*Q,const bf16*__restrict__ K,const bf16*__restrict__ V,bf16*O,const float*__restrict__ bias_h,char*shm){
  int tid_=threadIdx.x; asm volatile("":"+v"(tid_));
  const int tid=tid_,lane=tid&63,r32=lane&31,hi=lane>>5; const int wid=__builtin_amdgcn_readfirstlane(tid>>6);
  const long rowbase=(long)b*SEQ;
  const bf16*Kh=K+((long)b*KP+h)*(long)(NT_IMG*4096),*Vh=V+((long)b*KP+h)*(long)(NT_IMG*4096);
  const unsigned lds0=(unsigned)(uintptr_t)shm;
  float*wsf=(float*)(shm+N_LDS_WS)+wid*64;
  float*biasL=(float*)(shm+NAT_BIAS_OFF);
  const bf16*ksrc=Kh+wid*512+lane*8;
  const bf16*vsrc=Vh+wid*512+lane*8;
  const unsigned kdst=lds0+N_LDS_K+wid*1024, vdst=lds0+N_LDS_V+wid*1024;
  #define DMA_K(t,slot) glds16(ksrc+(long)(t)*4096,(unsigned)__builtin_amdgcn_readfirstlane(kdst+(slot)))
  #define DMA_V(t,slot) glds16(vsrc+(long)(t)*4096,(unsigned)__builtin_amdgcn_readfirstlane(vdst+(slot)))
  const int g=wid&3, R0=4*j+2*(wid>>2);
  const int kb=min(max(16*g-8,0),32);
  const int vb0=(int)(lds0+N_LDS_V)+((lane>>4)&1)*32+(lane&3)*8+(4*hi+((lane&15)>>2))*64+kb*64;
  const char*Kbase=shm+N_LDS_K+kb*16;
  const int wlo=min(max(R0-4,0),120), whi=min(max(R0-3,0),120)+7;
  const int kr_lo=min(max(4*j-4,0),120), kr_hi=min(max(4*j-1,0),120)+7, nt=kr_hi-kr_lo+1;
  const int qrow=R0+(r32>>4), qc=16*g+(r32&15);
  const int r0l=min(max(qrow-4,0),120), c0=min(max(qc-8,0),48);
  DMA_K(kr_lo,0);DMA_V(kr_lo,0);DMA_K(kr_lo+1,SLOTB);DMA_V(kr_lo+1,SLOTB);
  const bf16*Qw=Q+(rowbase+qrow*64+qc)*DM+h*D;
  bf16x8 qr[4];
  #pragma unroll
  for(int d0=0;d0<4;++d0)qr[d0]=*reinterpret_cast<const bf16x8*>(&Qw[d0*16+hi*8]);
  { const int i=tid; if(i<15*31){ const float bv=bias_h[i]; biasL[i]=bv*1.4426950408889634f; } }
  asm volatile("s_waitcnt vmcnt(0)":"+v"(qr[0]),"+v"(qr[1]),"+v"(qr[2]),"+v"(qr[3])::"memory");
  float m_run=-1e4f,l_reg=0.f;f32x16 o[2];o[0]=f32x16{};o[1]=f32x16{};
  const f32x16 zero16=f32x16{};
  #define NAT_TILE(kr,slot) do{ \
    if(kr>=wlo&&kr<=whi){ \
      f32x16 p0; \
      qkt32(p0,Kbase+slot,qr,zero16,r32,hi); \
      const float*brow=biasL+(kr-qrow+7)*31+(15-qc)+kb; \
      const bool rv=(kr>=r0l)&&(kr<r0l+8); \
      float bb0[16]; \
      _Pragma("unroll") \
      for(int r=0;r<16;++r)bb0[r]=brow[crow(r,hi)]; \
      _Pragma("unroll") \
      for(int r=0;r<16;r+=8)asm volatile("":"+v"(bb0[r]),"+v"(bb0[r+1]),"+v"(bb0[r+2]),"+v"(bb0[r+3]),"+v"(bb0[r+4]),"+v"(bb0[r+5]),"+v"(bb0[r+6]),"+v"(bb0[r+7])); \
      _Pragma("unroll") \
      for(int r=0;r<16;++r){ const int kc=kb+crow(r,hi); p0[r]=(rv&&((unsigned)(kc-c0)<16u))?p0[r]+bb0[r]:-1e30f; } \
      float rm=fmaxf(p0[0],p0[1]); \
      _Pragma("unroll") \
      for(int r=2;r<16;++r)rm=fmaxf(rm,p0[r]); \
      rm=fmaxf(rm,__shfl_xor(rm,32)); \
      if(__any(rm>m_run+8.f)){ \
        const float mn=fmaxf(m_run,rm); const float f=__builtin_amdgcn_exp2f(m_run-mn); m_run=mn; l_reg*=f; \
        if(hi==0)wsf[r32]=f; \
        asm volatile("s_waitcnt lgkmcnt(0)":::"memory"); \
        _Pragma("unroll") \
        for(int r=0;r<16;++r){ const float fr_=wsf[crow(r,hi)]; o[0][r]*=fr_; o[1][r]*=fr_; } \
      } \
      float ls=0.f; \
      _Pragma("unroll") \
      for(int r=0;r<16;++r){ p0[r]=__builtin_amdgcn_exp2f(p0[r]-m_run); ls+=p0[r]; } \
      l_reg+=ls; \
      u32x4 pw0,pw1; \
      pw0=(u32x4){cvtpk_s(p0[0],p0[1]),cvtpk_s(p0[2],p0[3]),cvtpk_s(p0[4],p0[5]),cvtpk_s(p0[6],p0[7])};pw1=(u32x4){cvtpk_s(p0[8],p0[9]),cvtpk_s(p0[10],p0[11]),cvtpk_s(p0[12],p0[13]),cvtpk_s(p0[14],p0[15])}; \
      SBAR(); pv32(o,vb0+slot,__builtin_bit_cast(bf16x8,pw0),__builtin_bit_cast(bf16x8,pw1)); \
    } \
  }while(0)
  for(int t=0;t<nt;t+=2){
    WAIT_BAR(0);
    if(t+2<nt){ DMA_K(kr_lo+t+2,((t+2)&3)*SLOTB); DMA_V(kr_lo+t+2,((t+2)&3)*SLOTB); }
    if(t+3<nt){ DMA_K(kr_lo+t+3,((t+3)&3)*SLOTB); DMA_V(kr_lo+t+3,((t+3)&3)*SLOTB); }
    NAT_TILE(kr_lo+t,(t&3)*SLOTB);
    if(t+1<nt) NAT_TILE(kr_lo+t+1,((t+1)&3)*SLOTB);
  }
  #undef NAT_TILE
  l_reg+=__shfl_xor(l_reg,32);
  if(hi==0)wsf[32+r32]=l_reg;asm volatile("s_waitcnt lgkmcnt(0)":::"memory");
  float rli[16];
  #pragma unroll
  for(int r=0;r<16;++r)rli[r]=__builtin_amdgcn_rcpf(wsf[32+crow(r,hi)]);
  { bf16*stg=(bf16*)(shm+N_LDS_OST)+wid*2048;
    #pragma unroll
    for(int r=0;r<16;++r){const int orow=crow(r,hi);
      #pragma unroll
      for(int d0=0;d0<2;++d0)stg[orow*64+d0*32+r32]=__float2bfloat16(o[d0][r]*rli[r]);}
    asm volatile("s_waitcnt lgkmcnt(0)":::"memory");
    #pragma unroll
    for(int i=0;i<4;++i){const int row=i*8+(lane>>3),ch=lane&7; const u32x4 v=*(const u32x4*)(stg+row*64+ch*8);
      ATTN_STORE16((char*)O+pg8::img_off((int)rowbase+(R0+(row>>4))*64+16*g+(row&15),h*D+ch*8,DM/64),v);} }
  asm volatile("s_waitcnt vmcnt(0) lgkmcnt(0)\n\ts_barrier":::"memory");
  #undef DMA_K
  #undef DMA_V
}
#undef SBAR
#undef WAIT_BAR
}
namespace pg8 {
constexpr float C2Q = 0.125f * 1.4426950408889634f;
constexpr float NEPS = 1e-6f;
__device__ __forceinline__ u32x4 pack8(const f32x4 a, const f32x4 b) { u32x4 w; w.x = cvt_pk_bf16(a[0], a[1]); w.y = cvt_pk_bf16(a[2], a[3]); w.z = cvt_pk_bf16(b[0], b[1]); w.w = cvt_pk_bf16(b[2], b[3]); return w; }
struct Carry8 { float s[8]; };
struct CarryNone {};
__device__ __forceinline__ void zero_acc(f32x4 (&acc)[2][2][4][2]) {
#pragma unroll
    for (int a = 0; a < 2; ++a)
#pragma unroll
        for (int b = 0; b < 2; ++b)
#pragma unroll
            for (int m = 0; m < 4; ++m)
#pragma unroll
                for (int n = 0; n < 2; ++n) acc[a][b][m][n] = (f32x4){0.f, 0.f, 0.f, 0.f};
}
__device__ __forceinline__ void load_ss8(Carry8& c, const float* ss, const Unit& u, int wr, int fr) {
#pragma unroll
    for (int ai = 0; ai < 2; ++ai)
#pragma unroll
        for (int m = 0; m < 4; ++m) c.s[ai * 4 + m] = ss[u.pm * BM + ai * HALF + wr * 64 + m * 16 + fr];
}
__device__ __forceinline__ float dot4(const f32x4 a) { return (a[0] * a[0] + a[1] * a[1]) + (a[2] * a[2] + a[3] * a[3]); }
template <int MODE> struct EpiQKV {
    static constexpr bool PERM = true, AFTER_DRAIN = false;
    typedef Carry8 Carry;
    __device__ __forceinline__ void init(f32x4 (&acc)[2][2][4][2], Carry& c, const Unit& u, int wr, int wc, int fr, int fq) const { zero_acc(acc); load_ss8(c, ss, u, wr, fr); }
    bf16_t* Q; long kofs, vofs; const float* ss; const float* rope;
    __device__ __forceinline__ void operator()(const f32x4 (&acc)[2][2][4][2], const Carry& cy, const Unit& u, int wr, int wc, int fr, int fq) const {
        int kind, headcol, head;
        constexpr int NHKV = (MODE == 0) ? 4 : 16;
        if (MODE == 0) { kind = u.pn < 4 ? 0 : u.pn - 3; headcol = (kind == 0 ? u.pn * 256 : 0) + wc * 64; head = wc; }
        else { kind = u.pn >> 2; headcol = (u.pn & 3) * 256 + wc * 64; head = (u.pn & 3) * 4 + wc; }
        bf16_t* dst = Q + (kind == 0 ? 0l : (kind == 1 ? kofs : vofs));
        const int cofs = headcol + 8 * fq;
        const int kvlane = (kind == 1) ? fq * 512 + fr * 8 : fr * 32 + fq * 8;
        const bool rot = (MODE == 0) && kind < 2;
        f32x4 g[2][2];
#pragma unroll
        for (int bj = 0; bj < 2; ++bj)
#pragma unroll
            for (int n = 0; n < 2; ++n) g[bj][n] = rot ? *(const f32x4*)(rope + 4096 + (kind == 0 ? 0 : 64) + 32 * bj + 8 * fq + 4 * n) : (f32x4){1.f, 1.f, 1.f, 1.f};
        const float outs = (kind == 0) ? C2Q : 1.f;
        const float sgn = (fq < 2) ? -1.f : 1.f;
#pragma unroll
        for (int ai = 0; ai < 2; ++ai)
#pragma unroll
            for (int m = 0; m < 4; ++m) {
                const int row = u.pm * BM + ai * HALF + wr * 64 + m * 16 + fr;
                const float rs = __builtin_amdgcn_rsqf(cy.s[ai * 4 + m] * (1.f / 1024.f) + NEPS);
                f32x4 v[2][2];
#pragma unroll
                for (int bj = 0; bj < 2; ++bj)
#pragma unroll
                    for (int n = 0; n < 2; ++n) v[bj][n] = acc[ai][bj][m][n] * rs;
                if (rot) {
                    float hs = (dot4(v[0][0]) + dot4(v[0][1])) + (dot4(v[1][0]) + dot4(v[1][1]));
                    hs += __shfl_xor(hs, 16); hs += __shfl_xor(hs, 32);
                    const float rn = __builtin_amdgcn_rsqf(hs * (1.f / 64.f) + NEPS);
                    const int t = row & 8191;
#pragma unroll
                    for (int bj = 0; bj < 2; ++bj) {
                        const int pos = bj ? (t & 63) : (t >> 6);
                        const float* rp = rope + pos * 32 + 8 * (fq & 1);
#pragma unroll
                        for (int n = 0; n < 2; ++n) {
                            const f32x4 c4 = *(const f32x4*)(rp + 4 * n); const f32x4 s4 = *(const f32x4*)(rp + 16 + 4 * n) * sgn;
                            const f32x4 x = v[bj][n] * rn * g[bj][n];
                            f32x4 p; p[0] = __shfl_xor(x[0], 32); p[1] = __shfl_xor(x[1], 32); p[2] = __shfl_xor(x[2], 32); p[3] = __shfl_xor(x[3], 32);
                            v[bj][n] = x * c4 + p * s4;
                        }
                    }
                }
#pragma unroll
                for (int bj = 0; bj < 2; ++bj) {
                    const u32x4 w8 = pack8(v[bj][0] * outs, v[bj][1] * outs);
                    if (kind == 0) __builtin_nontemporal_store(w8, (u32x4*)(dst + (size_t)row * 1024 + cofs + 32 * bj));
                    else {
                        const int rowblk = u.pm * 4 + ai * 2 + wr;
                        const size_t img = ((size_t)((rowblk >> 7) * NHKV + head) * 128 + (rowblk & 127)) * 4096;
                        *(u32x4*)(dst + img + kvlane + m * (kind == 1 ? 128 : 512) + bj * 2048) = w8;
                    }
                }
            }
    }
};
constexpr int U_HALF_IMGS = 65;
template <bool STORE = true> struct EpiRelu2T {
    static constexpr bool PERM = true, AFTER_DRAIN = false;
    bf16_t* U; const float* ss;
    typedef Carry8 Carry;
    __device__ __forceinline__ void init(f32x4 (&acc)[2][2][4][2], Carry& c, const Unit& u, int wr, int wc, int fr, int fq) const { zero_acc(acc); load_ss8(c, ss, u, wr, fr); }
    __device__ __forceinline__ void operator()(const f32x4 (&acc)[2][2][4][2], const Carry& cy, const Unit& u, int wr, int wc, int fr, int fq) const {
#pragma unroll
        for (int ai = 0; ai < 2; ++ai)
#pragma unroll
            for (int m = 0; m < 4; ++m) {
                const int row = u.pm * BM + ai * HALF + wr * 64 + m * 16 + fr;
                const float rs = __builtin_amdgcn_rsqf(cy.s[ai * 4 + m] * (1.f / 1024.f) + NEPS);
                char* rowp = (char*)U + ((size_t)(u.pm * 2 + ai) * U_HALF_IMGS + u.pn * 4 + wc) * 16384 + (wr * 8 + 2 * m) * 1024 + ((fr * 64 + 16 * fq) ^ ((fr & 8) << 2));
#pragma unroll
                for (int bj = 0; bj < 2; ++bj) {
                    f32x4 a = acc[ai][bj][m][0] * rs, b = acc[ai][bj][m][1] * rs;
#pragma unroll
                    for (int e = 0; e < 4; ++e) { a[e] = fmaxf(a[e], 0.f); b[e] = fmaxf(b[e], 0.f); }
                    if (STORE || a[0] == 1.2345e30f) __builtin_nontemporal_store(pack8(a * a, b * b), (u32x4*)(rowp + bj * 1024));
                }
            }
    }
};
struct EpiRes {
    static constexpr bool PERM = true, AFTER_DRAIN = false;
    bf16_t* xb; float* ssout;
    typedef CarryNone Carry;
    __device__ __forceinline__ void init(f32x4 (&acc)[2][2][4][2], Carry&, const Unit& u, int wr, int wc, int fr, int fq) const { zero_acc(acc); }
    __device__ __forceinline__ void operator()(const f32x4 (&acc)[2][2][4][2], const Carry&, const Unit& u, int wr, int wc, int fr, int fq) const {
#pragma unroll
        for (int ai = 0; ai < 2; ++ai)
#pragma unroll
            for (int m = 0; m < 4; ++m) {
                const int row = u.pm * BM + ai * HALF + wr * 64 + m * 16 + fr;
                char* rowp = (char*)xb + ((size_t)(u.pm * 2 + ai) * 16 + u.pn * 4 + wc) * 16384 + (wr * 8 + 2 * m) * 1024 + ((fr * 64 + 16 * fq) ^ ((fr & 8) << 2));
                float part = 0.f;
#pragma unroll
                for (int bj = 0; bj < 2; ++bj) {
                    const u32x4 w = *(const u32x4*)(rowp + bj * 1024);
                    const f32x4 b0 = {__uint_as_float(w.x << 16), __uint_as_float(w.x & 0xffff0000u), __uint_as_float(w.y << 16), __uint_as_float(w.y & 0xffff0000u)};
                    const f32x4 b1 = {__uint_as_float(w.z << 16), __uint_as_float(w.z & 0xffff0000u), __uint_as_float(w.w << 16), __uint_as_float(w.w & 0xffff0000u)};
                    const f32x4 o0 = b0 + acc[ai][bj][m][0], o1 = b1 + acc[ai][bj][m][1];
                    *(u32x4*)(rowp + bj * 1024) = pack8(o0, o1);
                    part += dot4(o0) + dot4(o1);
                }
                part += __shfl_xor(part, 16); part += __shfl_xor(part, 32);
                if (fq == 0) unsafeAtomicAdd(ssout + row, part);
            }
    }
};
typedef EpiRelu2T<true> EpiRelu2;
}
namespace cg = cooperative_groups;
constexpr int NWAVES = 8;
constexpr int DM_ = 1024, SEQ_ = 8192, NB_ = 6, M_ = NB_ * SEQ_, FF_ = 4096, NQKV_A = 1536, NQKV_B = 3072, M_PROMPT = 4 * SEQ_;
constexpr size_t MiB = 1u << 20;
constexpr size_t WS_SS = 0;
constexpr size_t SS_STRIDE = (size_t)M_ * 4;
constexpr size_t WS_ROPE = 5 * SS_STRIDE;
constexpr size_t WS_WIN = 1 * MiB, WS_WOUT = 9 * MiB;
constexpr size_t WS_XB = 17 * MiB;
constexpr size_t WS_U = 113 * MiB;
constexpr size_t WS_Q = 113 * MiB, WS_KA = 209 * MiB, WS_VA = 233 * MiB, WS_KB = 209 * MiB, WS_VB = 305 * MiB;
constexpr size_t WS_END = 504 * MiB;
constexpr int RING_BYTES = 131072, LDS_TOTAL = 147456, LDS_MISC = 131072;
constexpr size_t WS_BAR = 1024000;

#define GAS __attribute__((address_space(1)))
#define LAS __attribute__((address_space(3)))
typedef unsigned short bf16;
typedef unsigned v4u __attribute__((ext_vector_type(4)));
typedef float f32x4 __attribute__((ext_vector_type(4)));
__device__ __forceinline__ unsigned f2bf(float f) { unsigned u = __builtin_bit_cast(unsigned, f); return (u + 0x7fffu + ((u >> 16) & 1u)) >> 16; }
__device__ __forceinline__ unsigned pk2(float lo, float hi) { return f2bf(lo) | (f2bf(hi) << 16); }
#define RLX_AGENT __ATOMIC_RELAXED, __HIP_MEMORY_SCOPE_AGENT
#define XB_TMO      128
#define XB_XCNT(j)  (256  + 64 * (j))
#define XB_XSUB(j)  (1280 + 64 * (j))
#define XB_XGEN(j)  (2304 + 64 * (j))
#define XB_TOP      3328
#define XB_TOPGEN   3392
#define XCD_BAR_WORDS 3456
#define XB_SPIN_CAP (1u << 18)

__device__ __forceinline__ unsigned xb_ld(unsigned* p)              { return __hip_atomic_load(p, __ATOMIC_RELAXED, __HIP_MEMORY_SCOPE_AGENT); }
__device__ __forceinline__ unsigned xb_add(unsigned* p, unsigned v) { return __hip_atomic_fetch_add(p, v, __ATOMIC_RELAXED, __HIP_MEMORY_SCOPE_AGENT); }
__device__ __forceinline__ unsigned xb_xcc_id() { return (unsigned)__builtin_amdgcn_s_getreg((3 << 11) | 20) & 0xFu; }
#define XB_SPIN(cond, bar) do { unsigned _sp = 0; while (cond) { __builtin_amdgcn_s_sleep(1); \
    if ((++_sp & 255u) == 0u) { if (xb_ld(&(bar)[XB_TMO])) break; if (_sp > XB_SPIN_CAP) { atomicAdd(&(bar)[XB_TMO], 1u); break; } } } } while (0)

struct XcdBarrier {
    unsigned* bar; unsigned x;
    volatile LAS unsigned* st;
};

__device__ __forceinline__ XcdBarrier xcd_barrier_post(unsigned* bar, volatile LAS unsigned* st) {
    XcdBarrier b; b.bar = bar; b.x = xb_xcc_id(); b.st = st;
    if (threadIdx.x == 0) (void)xb_add(&bar[XB_XCNT(b.x)], 1u);
    return b;
}
__device__ __forceinline__ void xcd_barrier_complete(unsigned* bar, unsigned x, unsigned& nloc, unsigned& nx) {
    const unsigned G = gridDim.x * gridDim.y * gridDim.z;
    unsigned sum, cnt, mine, sp = 0u;
    for (;;) {
        sum = 0u; cnt = 0u; mine = 0u;
#pragma unroll
        for (unsigned j = 0; j < 16; ++j) { const unsigned c = xb_ld(&bar[XB_XCNT(j)]); sum += c; cnt += (c > 0u) ? 1u : 0u; mine = (j == x) ? c : mine; }
        if (sum == G) break;
        __builtin_amdgcn_s_sleep(1);
        if ((++sp & 255u) == 0u) { if (xb_ld(&bar[XB_TMO])) break; if (sp > XB_SPIN_CAP) { atomicAdd(&bar[XB_TMO], 1u); break; } }
    }
    nloc = mine > 0u ? mine : 1u; nx = cnt > 0u ? cnt : 1u;
}

__device__ __forceinline__ void xcd_barrier(const XcdBarrier& b) {
    asm volatile("s_waitcnt vmcnt(0)" ::: "memory");
    __syncthreads();
    if (threadIdx.x == 0) {
        unsigned* bar = b.bar;
        __builtin_amdgcn_s_waitcnt(0);
        unsigned nloc = b.st[0], nx = b.st[1];
        if (nloc == 0u) { xcd_barrier_complete(bar, b.x, nloc, nx); b.st[0] = nloc; b.st[1] = nx; }
        const unsigned old = xb_add(&bar[XB_XSUB(b.x)], 1u);
        const unsigned gen = old / nloc;
        if (old + 1u == (gen + 1u) * nloc) {
            __builtin_amdgcn_fence(__ATOMIC_RELEASE, "agent");
            asm volatile("s_waitcnt vmcnt(0)" ::: "memory");
            const unsigned og = xb_add(&bar[XB_TOP], 1u);
            const unsigned tg = og / nx;
            if (og + 1u == (tg + 1u) * nx) xb_add(&bar[XB_TOPGEN], 1u);
            else XB_SPIN(xb_ld(&bar[XB_TOPGEN]) == tg, bar);
            __builtin_amdgcn_fence(__ATOMIC_ACQUIRE, "agent");
            xb_add(&bar[XB_XGEN(b.x)], 1u);
            asm volatile("s_waitcnt vmcnt(0)" ::: "memory");
        } else {
            XB_SPIN(xb_ld(&bar[XB_XGEN(b.x)]) == gen, bar);
            __builtin_amdgcn_fence(__ATOMIC_ACQUIRE, "agent");
            asm volatile("s_waitcnt vmcnt(0)" ::: "memory");
        }
    }
    __syncthreads();
}
__device__ __forceinline__ float wave_sum(float v) {
#pragma unroll
    for (int o = 1; o < 64; o <<= 1) v += __shfl_xor(v, o);
    return v;
}
__device__ __forceinline__ void transpose_item(const float* __restrict__ W, int K, int N, const float* __restrict__ gain, bf16* WT, bool permute, float* scr, int item, int lane) {
    const int nblk = N / 32, kb = item / nblk, nb = item % nblk, k0 = 64 * kb, n0 = 32 * nb;
    {
        f32x4 wv[8];
#pragma unroll
        for (int i = 0; i < 8; ++i) wv[i] = *(const f32x4*)(W + (size_t)(k0 + 8 * i + (lane >> 3)) * N + n0 + 4 * (lane & 7));
#pragma unroll
        for (int i = 0; i < 8; ++i) { const int kk = 8 * i + (lane >> 3); const float gk = gain ? gain[k0 + kk] : 1.f; float* d = scr + kk * 33 + 4 * (lane & 7);
            d[0] = wv[i].x * gk; d[1] = wv[i].y * gk; d[2] = wv[i].z * gk; d[3] = wv[i].w * gk; }
    }
    asm volatile("s_waitcnt lgkmcnt(0)" ::: "memory");
    const int idx = (n0 >> 5) & 7; const int n0d = permute ? ((n0 & ~255) + ((((idx & 1) << 2) | (idx >> 1)) << 5)) : n0;
    const int c = lane & 7;
#pragma unroll
    for (int j = 0; j < 4; ++j) { const int n = (lane >> 3) + 8 * j; const float* s = scr + (8 * c) * 33 + n;
        v4u o; o.x = pk2(s[0 * 33], s[1 * 33]); o.y = pk2(s[2 * 33], s[3 * 33]); o.z = pk2(s[4 * 33], s[5 * 33]); o.w = pk2(s[6 * 33], s[7 * 33]);
        const int ng = n0d + n, nl = ng & 127, x = nl & 31, R = (nl & ~31) + 16 * ((x >> 2) & 1) + 4 * (x >> 3) + (x & 3);
        *(v4u*)((char*)WT + ((size_t)(ng >> 7) * (K / 64) + kb) * 16384 + pg8::lds_byte(R, 8 * c)) = o; }
    asm volatile("s_waitcnt lgkmcnt(0)" ::: "memory");
}
struct WJob { const float* W; int K, N; const float* gain; bf16* WT; int permute; };
__device__ __forceinline__ void convert_weights(const WJob* jobs, int njobs, float* scr, int gw, int NGW, int lane);

struct Args { const float* in[14]; float* out; unsigned char* ws; };

__global__ void __launch_bounds__(NWAVES * 64, 2) mk_fwd(Args args) {
    extern __shared__ __attribute__((aligned(16))) unsigned char lds[];
    cg::grid_group grid = cg::this_grid();
    const int tid = threadIdx.x, lane = tid & 63, wave = __builtin_amdgcn_readfirstlane(tid >> 6);
    const int G = gridDim.x, bx = blockIdx.x;
    const int gw = bx * NWAVES + wave, NGW = G * NWAVES;
    unsigned char* ws = args.ws;
    const float* xp = args.in[0]; const float* xs = args.in[1];
    const float* norm_mix = args.in[2]; const float* norm_mlp = args.in[3]; const float* norm_final = args.in[4];
    const float* a_w_qkv = args.in[5]; const float* a_q_norm = args.in[6]; const float* a_k_norm = args.in[7]; const float* a_w_o = args.in[8];
    const float* b_w_qkv = args.in[9]; const float* b_rel_bias = args.in[10]; const float* b_w_o = args.in[11];
    const float* mlp_w_in = args.in[12]; const float* mlp_w_out = args.in[13];
    float* out = args.out;
    float* ss = (float*)(ws + WS_SS); float* rope = (float*)(ws + WS_ROPE);
    bf16* Win_t = (bf16*)(ws + WS_WIN); bf16* Wout_t = (bf16*)(ws + WS_WOUT);
    bf16* Win1_t = (bf16*)out; bf16* Wout1_t = (bf16*)out + (size_t)FF_ * DM_;
    bf16* Ob = (bf16*)((unsigned char*)out + 16 * MiB);
    bf16* XB = (bf16*)(ws + WS_XB); bf16* U = (bf16*)(ws + WS_U);
    bf16* Qb = (bf16*)(ws + WS_Q); bf16* KA = (bf16*)(ws + WS_KA); bf16* VA = (bf16*)(ws + WS_VA); bf16* KB = (bf16*)(ws + WS_KB); bf16* VB = (bf16*)(ws + WS_VB);
    unsigned char* outb = (unsigned char*)out;
    bf16* WqkvA_t = (bf16*)(outb + 112 * MiB); bf16* WoA_t = (bf16*)(outb + 115 * MiB); bf16* WqkvB_t = (bf16*)(outb + 117 * MiB); bf16* WoB_t = (bf16*)(outb + 123 * MiB);
    LAS unsigned char* ldsp = (LAS unsigned char*)lds;
    float* scr = (float*)(lds + wave * 16384);

#define CONVERT(Wp, Kk, Nn, gainp, WTp, perm) do { const int nit_ = ((Kk) / 64) * ((Nn) / 32); for (int it_ = gw; it_ < nit_; it_ += NGW) transpose_item((Wp), (Kk), (Nn), (gainp), (WTp), (perm), scr, it_, lane); } while (0)

    if (tid < 2) ((volatile LAS unsigned*)(ldsp + LDS_MISC))[tid] = 0u;
    __syncthreads();
#ifdef PROBE_DUP_P0
    for (int rep_ = 0; rep_ < 2; ++rep_)
#endif
    {
        int tid0_ = threadIdx.x; asm volatile("" : "+v"(tid0_)); const int tid = tid0_, lane = tid0_ & 63;
        if (bx == 0) for (int i = tid; i < XCD_BAR_WORDS; i += NWAVES * 64) ((unsigned*)(ws + WS_BAR))[i] = 0u;
        CONVERT(a_w_qkv, DM_, NQKV_A, norm_mix, WqkvA_t, true);
        CONVERT(a_w_o, DM_, DM_, (const float*)nullptr, WoA_t, true);
        CONVERT(mlp_w_in, DM_, FF_, norm_mlp, Win_t, true);
        CONVERT(mlp_w_out, FF_, DM_, (const float*)nullptr, Wout_t, true);
        for (int m0 = gw; m0 < M_; m0 += 2 * NGW) {
            f32x4 v[2][4];
#pragma unroll
            for (int q = 0; q < 2; ++q) { const int m = m0 + q * NGW;
                const float* xrow = (m < M_PROMPT) ? xp + (size_t)m * DM_ : xs + (size_t)(m - M_PROMPT) * DM_;
                const f32x4* xr = (const f32x4*)xrow;
#pragma unroll
                for (int j = 0; j < 2; ++j) { v[q][2 * j] = xr[2 * (lane + 64 * j)]; v[q][2 * j + 1] = xr[2 * (lane + 64 * j) + 1]; } }
#pragma unroll
            for (int q = 0; q < 2; ++q) { const int m = m0 + q * NGW; float s = 0.f;
#pragma unroll
                for (int j = 0; j < 4; ++j) s += (v[q][j].x * v[q][j].x + v[q][j].y * v[q][j].y) + (v[q][j].z * v[q][j].z + v[q][j].w * v[q][j].w);
                s = wave_sum(s);
#pragma unroll
                for (int j = 0; j < 2; ++j) { v4u o; o.x = pk2(v[q][2 * j].x, v[q][2 * j].y); o.y = pk2(v[q][2 * j].z, v[q][2 * j].w); o.z = pk2(v[q][2 * j + 1].x, v[q][2 * j + 1].y); o.w = pk2(v[q][2 * j + 1].z, v[q][2 * j + 1].w);
                    *(v4u*)((char*)XB + pg8::img_off(m, 8 * (lane + 64 * j), DM_ / 64)) = o; }
                if (lane == 0) ss[m] = s; }
        }
        for (int i = bx * (NWAVES * 64) + tid; i < 4 * M_; i += G * NWAVES * 64) ss[M_ + i] = 0.f;
        for (int i = bx * (NWAVES * 64) + tid; i < 128 * 16; i += G * NWAVES * 64) {
            const int pos = i >> 4, fi = i & 15;
            const float inv = exp2f(-(float)fi * (13.287712379549449f / 16.f));
            const float ang = (float)pos * inv;
            const float k = rintf(ang * 0.15915494309189535f);
            float r = fmaf(-k, 6.2831854820251465f, ang); r = fmaf(-k, -1.7484555e-7f, r);
            const float xr = r * 0.15915494309189535f;
            rope[pos * 32 + fi] = __builtin_amdgcn_cosf(xr); rope[pos * 32 + 16 + fi] = __builtin_amdgcn_sinf(xr);
        }
        if (bx == 0 && tid < 128) rope[4096 + tid] = (tid < 64) ? a_q_norm[tid] : a_k_norm[tid - 64];
    }
    grid.sync();
    const XcdBarrier xbar = xcd_barrier_post((unsigned*)(ws + WS_BAR), (volatile LAS unsigned*)(ldsp + LDS_MISC));
#define GRID_SYNC() xcd_barrier(xbar)
#ifdef PROBE_SYNCS
    for (int rep_ = 0; rep_ < 12; ++rep_) GRID_SYNC();
#endif

#ifdef PROBE_DUP_P1
    for (int rep_ = 0; rep_ < 2; ++rep_)
#endif
    {
        pg8::Gemm g{XB, WqkvA_t, M_, NQKV_A, DM_, true}; pg8::StaticOrder S; S.init(M_, NQKV_A, G, bx);
        pg8::EpiQKV<0> E{Qb, (long)((WS_KA - WS_Q) / 2), (long)((WS_VA - WS_Q) / 2), ss, rope};
        pg8::gemm_phase<pg8::EpiQKV<0>, pg8::StaticOrder, PG8_ALIGN, PG8_SP2>(ldsp, g, S, E);
        if ((G != 256) || (bx >= 128)) {
            int tid1_ = threadIdx.x; asm volatile("" : "+v"(tid1_)); const int lane = tid1_ & 63;
            const int gw = (G != 256) ? (bx * NWAVES + wave) : ((bx - 128) * NWAVES + wave), NGW = (G != 256) ? G * NWAVES : 128 * NWAVES;
            CONVERT(b_w_qkv, DM_, NQKV_B, norm_mix + DM_, WqkvB_t, true);
            CONVERT(b_w_o, DM_, DM_, (const float*)nullptr, WoB_t, true);
            CONVERT(mlp_w_in + (size_t)DM_ * FF_, DM_, FF_, norm_mlp + DM_, Win1_t, true);
            CONVERT(mlp_w_out + (size_t)DM_ * FF_, FF_, DM_, (const float*)nullptr, Wout1_t, true);
        }
    }
    GRID_SYNC();

    {
        const int xcd = bx & 7, loc = bx >> 3;
#ifdef PROBE_DUP_ATTN
        constexpr int NREP_ = 24;
#else
        constexpr int NREP_ = 12;
#endif
        if (G == 256) {
            for (int ii = 0; ii < NREP_; ++ii) { const int i = ii % 12; const int grp = xcd * 3 + (i >> 2); const int b = grp >> 2, kvh = grp & 3, h = kvh * 4 + (i & 3);
                attn_body::bf16* Od = (NREP_ == 24 && ii < 12) ? (attn_body::bf16*)(ws + 257 * MiB) : (attn_body::bf16*)Ob;
                attn_body::attn_unit<8, 4>(b, h, kvh, loc, (const attn_body::bf16*)Qb, (const attn_body::bf16*)KA, (const attn_body::bf16*)VA, Od, (char*)lds); }
        } else {
            for (int L = bx; L < NB_ * 16 * 32; L += G) { const int qb = L & 31, h = (L >> 5) & 15, b = L >> 9;
                attn_body::attn_unit<8, 4>(b, h, h >> 2, qb, (const attn_body::bf16*)Qb, (const attn_body::bf16*)KA, (const attn_body::bf16*)VA, (attn_body::bf16*)Ob, (char*)lds); }
        }
        asm volatile("s_waitcnt vmcnt(0) lgkmcnt(0)" ::: "memory"); __syncthreads();
    }
    GRID_SYNC();

    {
        pg8::Gemm g{Ob, WoA_t, M_, DM_, DM_, true}; pg8::StaticOrder S; S.init(M_, DM_, G, bx);
        pg8::EpiRes E{XB, ss + 1 * M_};
        pg8::gemm_phase<pg8::EpiRes, pg8::StaticOrder, PG8_ALIGN, PG8_SP2>(ldsp, g, S, E);
    }
    GRID_SYNC();

#ifdef PROBE_DUP_MLPIN
    for (int rep_ = 0; rep_ < 2; ++rep_)
#endif
#ifdef PROBE_NOSTORE_MLPIN
    {
        pg8::Gemm g{XB, Win_t, M_, FF_, DM_, true}; pg8::StaticOrder S; S.init(M_, FF_, G, bx);
        pg8::EpiRelu2T<false> E{U, ss + 1 * M_};
        pg8::gemm_phase<pg8::EpiRelu2T<false>, pg8::StaticOrder, PG8_ALIGN, PG8_SP2>(ldsp, g, S, E);
    }
#endif
#ifdef PROBE_PARTSTORE_MLPIN
    {
        pg8::Gemm g{XB, Win_t, M_, FF_, DM_, true}; pg8::StaticOrder S; S.init(M_, FF_, G, bx);
        if ((bx >> 3) % PROBE_PARTSTORE_MLPIN == 0) { pg8::EpiRelu2T<true> E{U, ss + 1 * M_}; pg8::gemm_phase<pg8::EpiRelu2T<true>, pg8::StaticOrder, PG8_ALIGN, PG8_SP2>(ldsp, g, S, E); }
        else { pg8::EpiRelu2T<false> E{U, ss + 1 * M_}; pg8::gemm_phase<pg8::EpiRelu2T<false>, pg8::StaticOrder, PG8_ALIGN, PG8_SP2>(ldsp, g, S, E); }
    }
#endif
    {
        pg8::Gemm g{XB, Win_t, M_, FF_, DM_, true}; pg8::StaticOrder S; S.init(M_, FF_, G, bx);
        pg8::EpiRelu2 E{U, ss + 1 * M_};
        pg8::gemm_phase<pg8::EpiRelu2, pg8::StaticOrder, PG8_ALIGN, PG8_SP2>(ldsp, g, S, E);
    }
    GRID_SYNC();

#ifdef PROBE_DUP_P5
    {
#ifndef PROBE_P5_AMOD
#define PROBE_P5_AMOD 0
#endif
        pg8::Gemm g{U, Wout_t, M_, DM_, FF_, true, PROBE_P5_AMOD, (size_t)pg8::U_HALF_IMGS * 16384}; pg8::StaticOrder S; S.init(M_, DM_, G, bx);
        pg8::EpiRes E{Ob, (float*)((unsigned char*)out + 120 * MiB)};
        pg8::gemm_phase<pg8::EpiRes, pg8::StaticOrder, PG8_ALIGN, PG8_SP2>(ldsp, g, S, E);
    }
#endif
    {
        pg8::Gemm g{U, Wout_t, M_, DM_, FF_, true, 0, (size_t)pg8::U_HALF_IMGS * 16384}; pg8::StaticOrder S; S.init(M_, DM_, G, bx);
        pg8::EpiRes E{XB, ss + 2 * M_};
        pg8::gemm_phase<pg8::EpiRes, pg8::StaticOrder, PG8_ALIGN, PG8_SP2, 2>(ldsp, g, S, E);
    }
    GRID_SYNC();

    {
        pg8::Gemm g{XB, WqkvB_t, M_, NQKV_B, DM_, true}; pg8::StaticOrder S; S.init(M_, NQKV_B, G, bx);
        pg8::EpiQKV<1> E{Qb, (long)((WS_KB - WS_Q) / 2), (long)((WS_VB - WS_Q) / 2), ss + 2 * M_, rope};
        pg8::gemm_phase<pg8::EpiQKV<1>, pg8::StaticOrder, PG8_ALIGN, PG8_SP2>(ldsp, g, S, E);
    }
    GRID_SYNC();

    {
        const int xcd = bx & 7, loc = bx >> 3;
#ifdef PROBE_DUP_NATTEN
        for (int i = 0; i < 12; ++i) { const int bh = xcd * 12 + i; const int b = bh >> 4, h = bh & 15;
            attn_body::natten_unit<16>(b, h, loc, (const attn_body::bf16*)Qb, (const attn_body::bf16*)KB, (const attn_body::bf16*)VB, (attn_body::bf16*)(ws + 401 * MiB), b_rel_bias + h * 465, (char*)lds); }
#endif
        if (G == 256) {
            for (int i = 0; i < 12; ++i) { const int bh = xcd * 12 + i; const int b = bh >> 4, h = bh & 15;
                attn_body::natten_unit<16>(b, h, loc, (const attn_body::bf16*)Qb, (const attn_body::bf16*)KB, (const attn_body::bf16*)VB, (attn_body::bf16*)Ob, b_rel_bias + h * 465, (char*)lds); }
        } else {
            for (int L = bx; L < NB_ * 16 * 32; L += G) { const int j = L & 31, h = (L >> 5) & 15, b = L >> 9;
                attn_body::natten_unit<16>(b, h, j, (const attn_body::bf16*)Qb, (const attn_body::bf16*)KB, (const attn_body::bf16*)VB, (attn_body::bf16*)Ob, b_rel_bias + h * 465, (char*)lds); }
        }
        asm volatile("s_waitcnt vmcnt(0) lgkmcnt(0)" ::: "memory"); __syncthreads();
    }
    GRID_SYNC();

    {
        pg8::Gemm g{Ob, WoB_t, M_, DM_, DM_, true}; pg8::StaticOrder S; S.init(M_, DM_, G, bx);
        pg8::EpiRes E{XB, ss + 3 * M_};
        pg8::gemm_phase<pg8::EpiRes, pg8::StaticOrder, PG8_ALIGN, PG8_SP2>(ldsp, g, S, E);
    }
    GRID_SYNC();

    {
        pg8::Gemm g{XB, Win1_t, M_, FF_, DM_, true}; pg8::StaticOrder S; S.init(M_, FF_, G, bx);
        pg8::EpiRelu2 E{U, ss + 3 * M_};
        pg8::gemm_phase<pg8::EpiRelu2, pg8::StaticOrder, PG8_ALIGN, PG8_SP2>(ldsp, g, S, E);
    }
    GRID_SYNC();

    {
        pg8::Gemm g{U, Wout1_t, M_, DM_, FF_, true, 0, (size_t)pg8::U_HALF_IMGS * 16384}; pg8::StaticOrder S; S.init(M_, DM_, G, bx);
        pg8::EpiRes E{XB, ss + 4 * M_};
        pg8::gemm_phase<pg8::EpiRes, pg8::StaticOrder, PG8_ALIGN, PG8_SP2, 2>(ldsp, g, S, E);
    }
    GRID_SYNC();

    {
        const float* ss4 = ss + 4 * M_;
        int tid11_ = threadIdx.x; asm volatile("" : "+v"(tid11_)); const int lane = tid11_ & 63;
        f32x4 gn[2][2];
#pragma unroll
        for (int j = 0; j < 2; ++j) { gn[j][0] = ((const f32x4*)norm_final)[2 * (lane + 64 * j)]; gn[j][1] = ((const f32x4*)norm_final)[2 * (lane + 64 * j) + 1]; }
        for (int m0 = gw; m0 < M_; m0 += 2 * NGW) {
            v4u w[2][2];
#pragma unroll
            for (int q = 0; q < 2; ++q) { const int m = m0 + q * NGW; w[q][0] = *(const v4u*)((const char*)XB + pg8::img_off(m, 8 * lane, DM_ / 64)); w[q][1] = *(const v4u*)((const char*)XB + pg8::img_off(m, 8 * (lane + 64), DM_ / 64)); }
#pragma unroll
            for (int q = 0; q < 2; ++q) { const int m = m0 + q * NGW; const float rs = __builtin_amdgcn_rsqf(ss4[m] * (1.f / 1024.f) + 1e-6f);
                f32x4* orow = (f32x4*)(out + (size_t)m * DM_);
#pragma unroll
                for (int j = 0; j < 2; ++j) { const v4u t = w[q][j];
                    const f32x4 a = {__uint_as_float(t.x << 16), __uint_as_float(t.x & 0xffff0000u), __uint_as_float(t.y << 16), __uint_as_float(t.y & 0xffff0000u)};
                    const f32x4 b = {__uint_as_float(t.z << 16), __uint_as_float(t.z & 0xffff0000u), __uint_as_float(t.w << 16), __uint_as_float(t.w & 0xffff0000u)};
                    orow[2 * (lane + 64 * j)] = a * rs * gn[j][0]; orow[2 * (lane + 64 * j) + 1] = b * rs * gn[j][1]; } }
        }
    }
}

extern "C" void kernel_launch(void* const* d_in, const int* in_sizes, int n_in, void* d_out, int out_size, void* d_ws, size_t ws_size, hipStream_t stream) {
    static int grid = 0;
    if (grid == 0) {
        if (n_in != 14 || out_size != M_ * DM_ || ws_size < WS_END) { fprintf(stderr, "kernel_launch: unexpected shapes: n_in %d out %d ws %zu (need >= %zu)\n", n_in, out_size, ws_size, (size_t)WS_END); }
        int dev = 0, cus = 0, per_cu = 0;
        (void)hipGetDevice(&dev); (void)hipDeviceGetAttribute(&cus, hipDeviceAttributeMultiprocessorCount, dev);
        (void)hipFuncSetAttribute((const void*)mk_fwd, hipFuncAttributeMaxDynamicSharedMemorySize, LDS_TOTAL);
        if (hipOccupancyMaxActiveBlocksPerMultiprocessor(&per_cu, (const void*)mk_fwd, NWAVES * 64, LDS_TOTAL) != hipSuccess || per_cu < 1) per_cu = 1;
        (void)hipGetLastError();
        grid = cus * 1;
        if (grid <= 0) grid = 256;
    }
    Args a{};
    for (int i = 0; i < 14; ++i) a.in[i] = (const float*)d_in[i];
    a.out = (float*)d_out; a.ws = (unsigned char*)d_ws;
    void* kargs[] = {&a};
    hipError_t e = hipLaunchCooperativeKernel((const void*)mk_fwd, dim3(grid), dim3(NWAVES * 64), kargs, LDS_TOTAL, stream);
    if (e != hipSuccess) fprintf(stderr, "cooperative launch failed: %s (grid %d)\n", hipGetErrorString(e), grid);
}
```
